# Optimizing an MI355X kernel written in HIP

```python
import math
import jax, jax.numpy as jnp
from jax import lax
import numpy as np

D_MODEL = 1024
BATCH = 4
SEQ = 8192
DEPTH = 2
DEC_BATCH = 32
DEC_SEQ = 32
PAST_LEN = 1024

CHUNK = 64
N_A = DEPTH // 2
N_B = DEPTH - N_A
D_MIX = D_MODEL
CONV_W = 3
N_HEADS = 16
HEAD_DIM = D_MODEL // N_HEADS
D_ATT = N_HEADS * HEAD_DIM
D_FF = 2816
Q_BLOCK = 128
EPS = 1e-6

kernel_name = "yoco_shortconv_fox_convffn_step"


def _rmsnorm(x, g):
    xf = x.astype(jnp.float32)
    y = xf * lax.rsqrt(jnp.mean(xf * xf, axis=-1, keepdims=True) + EPS)
    return (y * g.astype(jnp.float32)).astype(x.dtype)


def _causal_dwconv(x, ctx, w):
    T = x.shape[1]
    xp = jnp.concatenate([ctx.astype(x.dtype), x], axis=1)
    y = xp[:, 0:T] * w[0]
    for i in range(1, CONV_W):
        y = y + xp[:, i:i + T] * w[i]
    return y, xp[:, T:]


def _mixer_a(h, ctx, w_in, conv_w, w_out):
    gb, gc, u = jnp.split(h @ w_in, 3, axis=-1)
    z, new_ctx = _causal_dwconv(gc * u, ctx, conv_w)
    return (gb * z) @ w_out, new_ctx


def _conv_ffn(h, ctx, w_up, conv_w, w_down):
    up = h @ w_up
    upc, new_ctx = _causal_dwconv(up, ctx, conv_w)
    g, v = jnp.split(upc, 2, axis=-1)
    return (jax.nn.silu(g) * v) @ w_down, new_ctx


def _fox_attend(q, k, v, cq, ck, qpos, kpos):
    s = jnp.einsum('bqhd,bkhd->bhqk', q, k).astype(jnp.float32) * (HEAD_DIM ** -0.5)
    s = s + jnp.swapaxes(cq, 1, 2)[..., :, None] - jnp.swapaxes(ck, 1, 2)[..., None, :]
    mask = kpos[None, :] <= qpos[:, None]
    s = jnp.where(mask, s, -jnp.inf)
    p = jax.nn.softmax(s, axis=-1)
    return jnp.einsum('bhqk,bkhd->bqhd', p.astype(v.dtype), v)


def _fox_mix(q, k_all, v_all, logf_all):
    B, T = q.shape[0], q.shape[1]
    Tk = k_all.shape[1]
    c = jnp.cumsum(logf_all.astype(jnp.float32), axis=1)
    cq = c[:, Tk - T:]
    kpos = jnp.arange(Tk)
    qpos = jnp.arange(Tk - T, Tk)
    if T % Q_BLOCK == 0:
        nb = T // Q_BLOCK
        qb = jnp.moveaxis(q.reshape(B, nb, Q_BLOCK, N_HEADS, HEAD_DIM), 1, 0)
        cqb = jnp.moveaxis(cq.reshape(B, nb, Q_BLOCK, N_HEADS), 1, 0)
        pb = qpos.reshape(nb, Q_BLOCK)
        ob = lax.map(lambda a: _fox_attend(a[0], k_all, v_all, a[1], c, a[2], kpos), (qb, cqb, pb))
        return jnp.moveaxis(ob, 0, 1).reshape(q.shape)
    return _fox_attend(q, k_all, v_all, cq, c, qpos, kpos)


def _trunk(x, sa, sf, past_k, past_v, past_logf,
           a_norm, w_a_in, a_conv_w, w_a_out, kv_norm, w_kv, b_f, b_norm, w_q, w_o,
           ffn_norm, w_ffn_up, ffn_conv_w, w_ffn_down, final_norm):
    B, T, _ = x.shape
    new_sa, new_sf = [], []
    k_new = v_new = logf_new = None
    k_all = v_all = logf_all = None
    for l in range(DEPTH):
        if l < N_A:
            y, st = _mixer_a(_rmsnorm(x, a_norm[l]), sa[l], w_a_in[l], a_conv_w[l], w_a_out[l])
            new_sa.append(st)
        else:
            j = l - N_A
            if j == 0:
                kvf = _rmsnorm(x, kv_norm) @ w_kv
                k_new = kvf[..., :D_ATT].reshape(B, T, N_HEADS, HEAD_DIM)
                v_new = kvf[..., D_ATT:2 * D_ATT].reshape(B, T, N_HEADS, HEAD_DIM)
                logf_new = jax.nn.log_sigmoid(kvf[..., 2 * D_ATT:].astype(jnp.float32)
                                              + b_f.astype(jnp.float32))
                if past_k is None:
                    k_all, v_all, logf_all = k_new, v_new, logf_new
                else:
                    k_all = jnp.concatenate([past_k.astype(k_new.dtype), k_new], axis=1)
                    v_all = jnp.concatenate([past_v.astype(v_new.dtype), v_new], axis=1)
                    logf_all = jnp.concatenate([past_logf.astype(jnp.float32), logf_new], axis=1)
            q = (_rmsnorm(x, b_norm[j]) @ w_q[j]).reshape(B, T, N_HEADS, HEAD_DIM)
            o = _fox_mix(q, k_all, v_all, logf_all)
            y = o.reshape(B, T, D_ATT) @ w_o[j]
        x = x + y
        f, st = _conv_ffn(_rmsnorm(x, ffn_norm[l]), sf[l], w_ffn_up[l], ffn_conv_w[l], w_ffn_down[l])
        new_sf.append(st)
        x = x + f
    return (_rmsnorm(x, final_norm), jnp.stack(new_sa), jnp.stack(new_sf),
            k_new, v_new, logf_new.astype(x.dtype))


def setup_inputs(seed: int = 0) -> dict:
    key = jax.random.key(seed)
    ks = jax.random.split(key, 24)
    f32 = jnp.float32
    nrm = lambda k, shape, s: jax.random.normal(k, shape, f32) * s
    gain = lambda k, shape: 1.0 + 0.01 * jax.random.normal(k, shape, f32)
    w_kv = nrm(ks[9], (D_MODEL, 2 * D_ATT + N_HEADS), D_MODEL ** -0.5)
    w_kv = w_kv.at[:, 2 * D_ATT:].multiply(0.1)
    return {
        "x_prompt": nrm(ks[0], (BATCH, SEQ, D_MODEL), 1.0),
        "x_sample": nrm(ks[1], (DEC_BATCH, DEC_SEQ, D_MODEL), 1.0),
        "state_conv_a": nrm(ks[2], (N_A, DEC_BATCH, CONV_W - 1, D_MIX), 1.0),
        "state_ffn_conv": nrm(ks[3], (DEPTH, DEC_BATCH, CONV_W - 1, 2 * D_FF), 1.0),
        "cache_k": nrm(ks[4], (DEC_BATCH, PAST_LEN, N_HEADS, HEAD_DIM), 1.0),
        "cache_v": nrm(ks[5], (DEC_BATCH, PAST_LEN, N_HEADS, HEAD_DIM), 1.0),
        "cache_logf": jax.nn.log_sigmoid(4.0 + 0.1 * jax.random.normal(ks[6], (DEC_BATCH, PAST_LEN, N_HEADS), f32)),
        "a_norm": gain(ks[7], (N_A, D_MODEL)),
        "w_a_in": nrm(ks[8], (N_A, D_MODEL, 3 * D_MIX), D_MODEL ** -0.5),
        "a_conv_w": nrm(ks[10], (N_A, CONV_W, D_MIX), CONV_W ** -0.5),
        "w_a_out": nrm(ks[11], (N_A, D_MIX, D_MODEL), D_MIX ** -0.5),
        "kv_norm": gain(ks[12], (D_MODEL,)),
        "w_kv": w_kv,
        "b_f": 4.0 + 0.1 * jax.random.normal(ks[13], (N_HEADS,), f32),
        "b_norm": gain(ks[14], (N_B, D_MODEL)),
        "w_q": nrm(ks[15], (N_B, D_MODEL, D_ATT), D_MODEL ** -0.5),
        "w_o": nrm(ks[16], (N_B, D_ATT, D_MODEL), D_ATT ** -0.5),
        "ffn_norm": gain(ks[17], (DEPTH, D_MODEL)),
        "w_ffn_up": nrm(ks[18], (DEPTH, D_MODEL, 2 * D_FF), D_MODEL ** -0.5),
        "ffn_conv_w": nrm(ks[19], (DEPTH, CONV_W, 2 * D_FF), CONV_W ** -0.5),
        "w_ffn_down": nrm(ks[20], (DEPTH, D_FF, D_MODEL), D_FF ** -0.5),
        "final_norm": gain(ks[21], (D_MODEL,)),
    }


def reference(x_prompt, x_sample, state_conv_a, state_ffn_conv, cache_k, cache_v, cache_logf,
              a_norm, w_a_in, a_conv_w, w_a_out, kv_norm, w_kv, b_f, b_norm, w_q, w_o,
              ffn_norm, w_ffn_up, ffn_conv_w, w_ffn_down, final_norm):
    weights = (a_norm, w_a_in, a_conv_w, w_a_out, kv_norm, w_kv, b_f, b_norm, w_q, w_o,
               ffn_norm, w_ffn_up, ffn_conv_w, w_ffn_down, final_norm)
    Bp = x_prompt.shape[0]
    sa0 = jnp.zeros((N_A, Bp, CONV_W - 1, D_MIX), x_prompt.dtype)
    sf0 = jnp.zeros((DEPTH, Bp, CONV_W - 1, 2 * D_FF), x_prompt.dtype)
    y_prompt, p_conv_a, p_ffn_conv, p_k, p_v, p_logf = _trunk(
        x_prompt, sa0, sf0, None, None, None, *weights)
    y_sample, s_conv_a, s_ffn_conv, s_k, s_v, s_logf = _trunk(
        x_sample, state_conv_a, state_ffn_conv, cache_k, cache_v, cache_logf, *weights)
    return (y_prompt, y_sample, p_conv_a, p_ffn_conv, p_k, p_v, p_logf,
            s_conv_a, s_ffn_conv, s_k, s_v, s_logf)
```

```cpp
#include <hip/hip_runtime.h>
#include <hip/hip_cooperative_groups.h>
#include <cstdio>
#include <cstdint>
constexpr int NWAVES = 8;
constexpr int DM = 1024, TP = 8192, MP = 32768, MS = 1024, M = MP + MS, FF = 2816, FF2 = 5632;
constexpr float LOG2E = 1.4426950408889634f;
constexpr size_t MiB = 1u << 20;
constexpr int SSQ_SLOTS = 32;
constexpr size_t SSQ_BYTES = (size_t)M * SSQ_SLOTS * 4;
constexpr size_t WS_SSQ0 = 0, WS_SSQ1 = WS_SSQ0 + SSQ_BYTES, WS_SSQ2 = WS_SSQ1 + SSQ_BYTES, WS_SSQ3 = WS_SSQ2 + SSQ_BYTES, WS_SSQ4 = WS_SSQ3 + SSQ_BYTES;
constexpr size_t WS_LOGF = WS_SSQ4 + SSQ_BYTES;
constexpr size_t WS_CS = WS_LOGF + 3 * MiB;
constexpr size_t WS_TOT = WS_CS + 2 * MiB;
constexpr size_t WS_HALO = WS_TOT + 64 * 1024;
constexpr size_t WS_CTL = 31 * MiB + 512 * 1024;
constexpr size_t QMiB = MiB / 4;
constexpr size_t WS_WAIN = 127 * QMiB, WS_WAOUT = WS_WAIN + 6 * MiB, WS_WUP = WS_WAOUT + 2 * MiB, WS_WDN = WS_WUP + 22 * MiB, WS_WKVQ = WS_WDN + 11 * MiB, WS_WO = WS_WKVQ + 26 * QMiB;
constexpr size_t WS_X = WS_WO + 2 * MiB + QMiB, WS_BIG = WS_X + 66 * MiB, X_BYTES = (size_t)M * DM * 2;
constexpr size_t WS_CU = WS_BIG, WS_GB = WS_BIG + X_BYTES, WS_MB = WS_BIG + 2 * X_BYTES;
constexpr size_t WS_QB = WS_BIG, WS_KB = WS_BIG + X_BYTES, WS_VB = WS_BIG + 2 * X_BYTES;
constexpr size_t WS_UP = WS_BIG, WS_END = WS_BIG + (size_t)M * FF2 * 2;
static_assert(WS_HALO + (size_t)264 * 2 * FF2 * 2 <= WS_CTL && WS_WKVQ + (size_t)3328 * 1024 * 2 <= WS_WO && WS_WDN + (size_t)2 * 1024 * FF * 2 <= WS_WKVQ && WS_END <= 512 * MiB, "ws map");
constexpr int LDS_BYTES = 147456;


namespace pg8 {
#define PG8_LAS __attribute__((address_space(3)))
typedef unsigned short bf16_t;
typedef short bf16x8 __attribute__((ext_vector_type(8)));
typedef float f32x4 __attribute__((ext_vector_type(4)));
typedef unsigned u32x4 __attribute__((ext_vector_type(4)));
constexpr int BM = 256, BK = 64, HALF = 128, HTB = HALF * BK * 2  , STAGE_BYTES = 8 * HTB, NXCD = 8, WGM = 4;

__host__ __device__ __forceinline__ int lds_byte(int r, int c) { const int st = (r >> 4) * 2 + (c >> 5), rr = r & 15, cc = c & 31, ob = rr * 64 + cc * 2; return st * 1024 + (ob ^ (((ob >> 9) & 1) << 5)); }
__host__ __device__ __forceinline__ void stage_rc(int b, int& R, int& C) { const int st = b / 1024, sb = b % 1024, swz = sb ^ (((sb >> 9) & 1) << 5); R = (st >> 1) * 16 + swz / 64; C = (st & 1) * 32 + (swz % 64) / 2; }
__host__ __device__ __forceinline__ int perm32(int rho) { const int n = rho >> 4, i = rho & 15; return 8 * (i >> 2) + 4 * n + (i & 3); }

struct Unit { int pm, pn; };
struct Gemm { const bf16_t* A; const bf16_t* Bt; int M, N, K; int lda; int apair; };

struct StaticOrder {
    int nM, nN, nwg, G, c;
    __host__ __device__ void init(int M, int N, int G_, int c_) { nM = M / BM; nN = N / BM; nwg = nM * nN; G = G_; c = c_; }
    __host__ __device__ bool next(int i, Unit& u) const {
        const long L = (long)i * G + c; if (L >= nwg) return false;
        int wgid = (int)L; { const int q = nwg / NXCD, r = nwg % NXCD, xcd = wgid % NXCD, off = wgid / NXCD; wgid = (xcd < r ? xcd * (q + 1) : r * (q + 1) + (xcd - r) * q) + off; }
        const int nig = WGM * nN, gid = wgid / nig, fm = gid * WGM, gsz = (nM - fm) < WGM ? (nM - fm) : WGM;
        u.pm = fm + ((wgid % nig) % gsz); u.pn = (wgid % nig) / gsz; return true;
    }
    __device__ __forceinline__ void a_ready(const Unit&) const {}
    __device__ __forceinline__ void done(const Unit&) const {}
};

__device__ __forceinline__ unsigned cvt_pk_bf16(float lo, float hi) { unsigned r; asm volatile("v_cvt_pk_bf16_f32 %0, %1, %2" : "=v"(r) : "v"(lo), "v"(hi)); return r; }
#define GAS1 __attribute__((address_space(1)))
constexpr float RMS_EPS = 1e-6f;
constexpr float Q_C2 = 0.125f * 1.4426950408889634f;
constexpr long O_YP = 0, O_YS = 33554432L, O_PCA = O_YS + 1048576L, O_PFC = O_PCA + 8192L, O_PK = O_PFC + 90112L, O_PV = O_PK + 33554432L, O_PLF = O_PV + 33554432L,
               O_SCA = O_PLF + 524288L, O_SFC = O_SCA + 65536L, O_SK = O_SFC + 720896L, O_SV = O_SK + 1048576L, O_SLF = O_SV + 1048576L, O_END = O_SLF + 16384L;
constexpr int MPROMPT = 32768;
__device__ __forceinline__ float row_rs(const float* ssq, int row, int fq) {
    const f32x4 p = *(const GAS1 f32x4*)(ssq + (size_t)row * SSQ_SLOTS + 4 * fq), q = *(const GAS1 f32x4*)(ssq + (size_t)row * SSQ_SLOTS + 16 + 4 * fq);
    float s = ((p[0] + p[1]) + (p[2] + p[3])) + ((q[0] + q[1]) + (q[2] + q[3]));
    s += __shfl_xor(s, 16); s += __shfl_xor(s, 32);
    return __builtin_amdgcn_rsqf(s * (1.0f / 1024.0f) + RMS_EPS);
}
typedef unsigned u32x2 __attribute__((ext_vector_type(2)));
__device__ __forceinline__ u32x2 pack4(const f32x4 v) { u32x2 w; w.x = cvt_pk_bf16(v[0], v[1]); w.y = cvt_pk_bf16(v[2], v[3]); return w; }
__device__ __forceinline__ u32x4 pack8(const f32x4 v0, const f32x4 v1) { u32x4 w; w.x = cvt_pk_bf16(v0[0], v0[1]); w.y = cvt_pk_bf16(v0[2], v0[3]); w.z = cvt_pk_bf16(v1[0], v1[1]); w.w = cvt_pk_bf16(v1[2], v1[3]); return w; }
__device__ __forceinline__ float logsigmoidf(float x) { return x > 0.f ? -log1pf(expf(-x)) : x - log1pf(expf(x)); }
enum EpiMode { EPI_MIX = 0, EPI_RESID = 1, EPI_UP = 2, EPI_KVQ = 3, EPI_NOP = 4, EPI_UP_NOST = 5, EPI_UP_NOLD = 6 };
struct EpiAny {
    static constexpr bool PERM = true, AFTER_DRAIN = false;
    int mode, sel; unsigned char* ws; float* out; const float* b_f;
    __device__ __forceinline__ void operator()(const f32x4 (&acc)[2][2][4][2], const Unit& u, int wr, int wc, int fr_in, int fq_in) const {
        int lane_ = fr_in | (fq_in << 4); asm volatile("" : "+v"(lane_));
        const int fr = lane_ & 15, fq = lane_ >> 4, colw = wc * 32 + 8 * fq;
        unsigned char* ws = this->ws; asm volatile("" : "+s"(ws));
        if (mode == EPI_NOP) {
#pragma unroll
            for (int ai = 0; ai < 2; ++ai)
#pragma unroll
                for (int bj = 0; bj < 2; ++bj)
#pragma unroll
                    for (int m = 0; m < 4; ++m) { asm volatile("" :: "v"(acc[ai][bj][m][0]), "v"(acc[ai][bj][m][1])); }
            return;
        }
        const float* ssq = (const float*)(ws + WS_SSQ0 + (size_t)sel * SSQ_BYTES); GAS1 float* ssq_out = (GAS1 float*)(ws + WS_SSQ0 + (size_t)sel * SSQ_BYTES);
        bf16_t* P0 = (bf16_t*)(ws + (mode == EPI_RESID ? WS_X : WS_BIG));
        bf16_t* P1 = (bf16_t*)(ws + (mode == EPI_UP ? WS_HALO : (mode == EPI_MIX ? WS_GB : WS_VB)));
        if (mode == EPI_KVQ) P0 = (bf16_t*)(ws + WS_KB);
        bf16_t* P2 = (bf16_t*)(ws + WS_QB); float* LOGF = (float*)(ws + WS_LOGF);
        if (mode == EPI_RESID) {
#pragma unroll
            for (int ai = 0; ai < 2; ++ai) {
                u32x4 old[4][2];
#pragma unroll
                for (int m = 0; m < 4; ++m)
#pragma unroll
                    for (int bj = 0; bj < 2; ++bj) old[m][bj] = *(const GAS1 u32x4*)(P0 + (size_t)(u.pm * BM + ai * HALF + wr * 64 + m * 16 + fr) * 1024 + u.pn * BM + bj * HALF + colw);
                asm volatile("" : "+v"(old[0][0]), "+v"(old[0][1]), "+v"(old[1][0]), "+v"(old[1][1]), "+v"(old[2][0]), "+v"(old[2][1]), "+v"(old[3][0]), "+v"(old[3][1]));
#pragma unroll
                for (int m = 0; m < 4; ++m) {
                    const int row = u.pm * BM + ai * HALF + wr * 64 + m * 16 + fr; float ss = 0.f;
#pragma unroll
                    for (int bj = 0; bj < 2; ++bj) {
                        bf16_t* p = P0 + (size_t)row * 1024 + u.pn * BM + bj * HALF + colw;
                        const u32x4 o = old[m][bj];
                        f32x4 r0, r1;
                        r0[0] = __uint_as_float(o.x << 16); r0[1] = __uint_as_float(o.x & 0xffff0000u); r0[2] = __uint_as_float(o.y << 16); r0[3] = __uint_as_float(o.y & 0xffff0000u);
                        r1[0] = __uint_as_float(o.z << 16); r1[1] = __uint_as_float(o.z & 0xffff0000u); r1[2] = __uint_as_float(o.w << 16); r1[3] = __uint_as_float(o.w & 0xffff0000u);
                        const f32x4 v0 = acc[ai][bj][m][0] + r0, v1 = acc[ai][bj][m][1] + r1;
                        ss += (v0[0] * v0[0] + v0[1] * v0[1]) + (v0[2] * v0[2] + v0[3] * v0[3]) + (v1[0] * v1[0] + v1[1] * v1[1]) + (v1[2] * v1[2] + v1[3] * v1[3]);
                        *(u32x4*)p = pack8(v0, v1);
                    }
                    ss += __shfl_xor(ss, 16); ss += __shfl_xor(ss, 32);
                    if (fq < 2) ssq_out[(size_t)row * SSQ_SLOTS + u.pn * 8 + wc * 2 + fq] = fq == 0 ? ss : 0.f;
                }
            }
            return;
        }
        float rs8[2][4];
#pragma unroll
        for (int ai = 0; ai < 2; ++ai)
#pragma unroll
            for (int m = 0; m < 4; ++m) rs8[ai][m] = 1.0f;
        if (mode != EPI_UP) {
            f32x4 pp[2][4], qq[2][4];
#pragma unroll
            for (int ai = 0; ai < 2; ++ai)
#pragma unroll
                for (int m = 0; m < 4; ++m) { const GAS1 float* sp = (const GAS1 float*)ssq + (size_t)(u.pm * BM + ai * HALF + wr * 64 + m * 16 + fr) * SSQ_SLOTS + 4 * fq; pp[ai][m] = *(const GAS1 f32x4*)sp; qq[ai][m] = *(const GAS1 f32x4*)(sp + 16); }
            asm volatile("" : "+v"(pp[0][0]), "+v"(pp[0][1]), "+v"(pp[0][2]), "+v"(pp[0][3]), "+v"(qq[0][0]), "+v"(qq[0][1]), "+v"(qq[0][2]), "+v"(qq[0][3]),
                              "+v"(pp[1][0]), "+v"(pp[1][1]), "+v"(pp[1][2]), "+v"(pp[1][3]), "+v"(qq[1][0]), "+v"(qq[1][1]), "+v"(qq[1][2]), "+v"(qq[1][3]));
#pragma unroll
            for (int ai = 0; ai < 2; ++ai)
#pragma unroll
                for (int m = 0; m < 4; ++m) rs8[ai][m] = ((pp[ai][m][0] + pp[ai][m][1]) + (pp[ai][m][2] + pp[ai][m][3])) + ((qq[ai][m][0] + qq[ai][m][1]) + (qq[ai][m][2] + qq[ai][m][3]));
#pragma unroll
            for (int ai = 0; ai < 2; ++ai)
#pragma unroll
                for (int m = 0; m < 4; ++m) rs8[ai][m] += __shfl_xor(rs8[ai][m], 16);
#pragma unroll
            for (int ai = 0; ai < 2; ++ai)
#pragma unroll
                for (int m = 0; m < 4; ++m) rs8[ai][m] += __shfl_xor(rs8[ai][m], 32);
#pragma unroll
            for (int ai = 0; ai < 2; ++ai)
#pragma unroll
                for (int m = 0; m < 4; ++m) rs8[ai][m] = __builtin_amdgcn_rsqf(rs8[ai][m] * (1.0f / 1024.0f) + RMS_EPS);
        }
#pragma unroll
        for (int ai = 0; ai < 2; ++ai)
#pragma unroll
            for (int m = 0; m < 4; ++m) {
                const int row = u.pm * BM + ai * HALF + wr * 64 + m * 16 + fr;
                const float rs = rs8[ai][m];
                if (mode == EPI_MIX) {
                    if (u.pn < 8) {
                        const f32x4 g0 = acc[ai][0][m][0] * rs, g1 = acc[ai][0][m][1] * rs, u0 = acc[ai][1][m][0] * rs, u1 = acc[ai][1][m][1] * rs;
                        *(GAS1 u32x4*)(P0 + (size_t)row * 1024 + 128 * u.pn + colw) = pack8(g0 * u0, g1 * u1);
                    } else {
#pragma unroll
                        for (int bj = 0; bj < 2; ++bj)
                            *(GAS1 u32x4*)(P1 + (size_t)row * 1024 + 256 * (u.pn - 8) + bj * HALF + colw) = pack8(acc[ai][bj][m][0] * rs, acc[ai][bj][m][1] * rs);
                    }
                } else if (mode == EPI_UP_NOLD) {
                    asm volatile("" :: "v"(rs));
                } else if (mode == EPI_UP_NOST) {
#pragma unroll
                    for (int bj = 0; bj < 2; ++bj) { const u32x4 w = pack8(acc[ai][bj][m][0] * rs, acc[ai][bj][m][1] * rs); asm volatile("" :: "v"(w)); }
                } else if (mode == EPI_UP) {
#pragma unroll
                    for (int bj = 0; bj < 2; ++bj) {
                        const u32x4 w = pack8(acc[ai][bj][m][0] * rs, acc[ai][bj][m][1] * rs);
                        *(GAS1 u32x4*)(P0 + (size_t)row * 5632 + u.pn * BM + bj * HALF + colw) = w;
                        if (wr == 1 && m == 3 && fr >= 14) *(GAS1 u32x4*)(P1 + (size_t)((2 * u.pm + ai) * 2 + (fr - 14)) * 5632 + u.pn * BM + bj * HALF + colw) = w;
                    }
                } else {
                    if (u.pn < 8) {
                        const int kv = u.pn >> 2, cb = 256 * (u.pn & 3);
                        bf16_t* db = (kv ? P1 : P0) + (size_t)row * 1024 + cb + colw;
                        float* df = (row < MPROMPT) ? out + (kv ? O_PV : O_PK) + (size_t)row * 1024 + cb + colw : out + (kv ? O_SV : O_SK) + (size_t)(row - MPROMPT) * 1024 + cb + colw;
#pragma unroll
                        for (int bj = 0; bj < 2; ++bj) {
                            const f32x4 v0 = acc[ai][bj][m][0] * rs, v1 = acc[ai][bj][m][1] * rs;
                            *(GAS1 u32x4*)(db + bj * HALF) = pack8(v0, v1);
                            __builtin_nontemporal_store(v0, (GAS1 f32x4*)(df + bj * HALF)); __builtin_nontemporal_store(v1, (GAS1 f32x4*)(df + bj * HALF + 4));
                        }
                    } else if (u.pn < 12) {
#pragma unroll
                        for (int bj = 0; bj < 2; ++bj)
                            *(GAS1 u32x4*)(P2 + (size_t)row * 1024 + 256 * (u.pn - 8) + bj * HALF + colw) = pack8(acc[ai][bj][m][0] * (rs * Q_C2), acc[ai][bj][m][1] * (rs * Q_C2));
                    } else if (wc == 0 && fq < 2) {
                        f32x4 v0 = acc[ai][0][m][0] * rs, v1 = acc[ai][0][m][1] * rs;
                        const f32x4 b0 = *(const GAS1 f32x4*)(b_f + 8 * fq), b1 = *(const GAS1 f32x4*)(b_f + 8 * fq + 4);
#pragma unroll
                        for (int e = 0; e < 4; ++e) { v0[e] = logsigmoidf(v0[e] + b0[e]); v1[e] = logsigmoidf(v1[e] + b1[e]); }
                        *(GAS1 f32x4*)(LOGF + (size_t)row * 16 + 8 * fq) = v0; *(GAS1 f32x4*)(LOGF + (size_t)row * 16 + 8 * fq + 4) = v1;
                        float* df = (row < MPROMPT) ? out + O_PLF + (size_t)row * 16 + 8 * fq : out + O_SLF + (size_t)(row - MPROMPT) * 16 + 8 * fq;
                        *(f32x4*)df = v0; *(GAS1 f32x4*)(df + 4) = v1;
                    }
                }
            }
    }

    __device__ __forceinline__ void small(const f32x4 (&acc)[2][4], int row0, int pn, int w, int fr, int fq) const {
        const int colw = 16 * w + 4 * fq;
        const float* ssq = (const float*)(ws + WS_SSQ0 + (size_t)sel * SSQ_BYTES); GAS1 float* ssq_out = (GAS1 float*)(ws + WS_SSQ0 + (size_t)sel * SSQ_BYTES);
        if (mode == EPI_NOP) {
#pragma unroll
            for (int bj = 0; bj < 2; ++bj)
#pragma unroll
                for (int m = 0; m < 4; ++m) { asm volatile("" :: "v"(acc[bj][m])); }
            return;
        }
        if (mode == EPI_RESID) {
            bf16_t* X = (bf16_t*)(ws + WS_X);
            u32x2 old[4][2];
#pragma unroll
            for (int m = 0; m < 4; ++m)
#pragma unroll
                for (int bj = 0; bj < 2; ++bj) old[m][bj] = *(const GAS1 u32x2*)(X + (size_t)(row0 + 16 * m + fr) * 1024 + pn * BM + bj * HALF + colw);
#pragma unroll
            for (int m = 0; m < 4; ++m) {
                const int row = row0 + 16 * m + fr; float ss = 0.f;
#pragma unroll
                for (int bj = 0; bj < 2; ++bj) {
                    bf16_t* p = X + (size_t)row * 1024 + pn * BM + bj * HALF + colw;
                    const u32x2 o = old[m][bj]; f32x4 r;
                    r[0] = __uint_as_float(o.x << 16); r[1] = __uint_as_float(o.x & 0xffff0000u); r[2] = __uint_as_float(o.y << 16); r[3] = __uint_as_float(o.y & 0xffff0000u);
                    const f32x4 v = acc[bj][m] + r;
                    ss += (v[0] * v[0] + v[1] * v[1]) + (v[2] * v[2] + v[3] * v[3]);
                    *(u32x2*)p = pack4(v);
                }
                ss += __shfl_xor(ss, 16); ss += __shfl_xor(ss, 32);
                if (fq == 0) ssq_out[(size_t)row * SSQ_SLOTS + pn * 8 + w] = ss;
            }
            return;
        }
        float rs4[4];
        {
            f32x4 pp[4], qq[4];
#pragma unroll
            for (int m = 0; m < 4; ++m) { const GAS1 float* sp = (const GAS1 float*)ssq + (size_t)(row0 + 16 * m + fr) * SSQ_SLOTS + 4 * fq; pp[m] = *(const GAS1 f32x4*)sp; qq[m] = *(const GAS1 f32x4*)(sp + 16); }
            asm volatile("" : "+v"(pp[0]), "+v"(pp[1]), "+v"(pp[2]), "+v"(pp[3]), "+v"(qq[0]), "+v"(qq[1]), "+v"(qq[2]), "+v"(qq[3]));
#pragma unroll
            for (int m = 0; m < 4; ++m) rs4[m] = ((pp[m][0] + pp[m][1]) + (pp[m][2] + pp[m][3])) + ((qq[m][0] + qq[m][1]) + (qq[m][2] + qq[m][3]));
#pragma unroll
            for (int m = 0; m < 4; ++m) rs4[m] += __shfl_xor(rs4[m], 16);
#pragma unroll
            for (int m = 0; m < 4; ++m) rs4[m] += __shfl_xor(rs4[m], 32);
#pragma unroll
            for (int m = 0; m < 4; ++m) rs4[m] = __builtin_amdgcn_rsqf(rs4[m] * (1.0f / 1024.0f) + RMS_EPS);
        }
#pragma unroll
        for (int m = 0; m < 4; ++m) {
            const int row = row0 + 16 * m + fr;
            const float rs = rs4[m];
            if (mode == EPI_MIX) {
                if (pn < 8) *(GAS1 u32x2*)((bf16_t*)(ws + WS_CU) + (size_t)row * 1024 + 128 * pn + colw) = pack4((acc[0][m] * rs) * (acc[1][m] * rs));
                else {
#pragma unroll
                    for (int bj = 0; bj < 2; ++bj) *(GAS1 u32x2*)((bf16_t*)(ws + WS_GB) + (size_t)row * 1024 + 256 * (pn - 8) + bj * HALF + colw) = pack4(acc[bj][m] * rs);
                }
            } else if (mode == EPI_UP) {
#pragma unroll
                for (int bj = 0; bj < 2; ++bj) *(GAS1 u32x2*)((bf16_t*)(ws + WS_UP) + (size_t)row * 5632 + pn * BM + bj * HALF + colw) = pack4(acc[bj][m] * rs);
            } else {
                if (pn < 8) {
                    const int kv = pn >> 2, cb = 256 * (pn & 3);
                    bf16_t* db = (bf16_t*)(ws + (kv ? WS_VB : WS_KB)) + (size_t)row * 1024 + cb + colw;
                    float* df = (row < MPROMPT) ? out + (kv ? O_PV : O_PK) + (size_t)row * 1024 + cb + colw : out + (kv ? O_SV : O_SK) + (size_t)(row - MPROMPT) * 1024 + cb + colw;
#pragma unroll
                    for (int bj = 0; bj < 2; ++bj) { const f32x4 v = acc[bj][m] * rs; *(GAS1 u32x2*)(db + bj * HALF) = pack4(v); *(GAS1 f32x4*)(df + bj * HALF) = v; }
                } else if (pn < 12) {
#pragma unroll
                    for (int bj = 0; bj < 2; ++bj) *(GAS1 u32x2*)((bf16_t*)(ws + WS_QB) + (size_t)row * 1024 + 256 * (pn - 8) + bj * HALF + colw) = pack4(acc[bj][m] * (rs * Q_C2));
                } else if (w == 0) {
                    f32x4 v = acc[0][m] * rs; const f32x4 b0 = *(const GAS1 f32x4*)(b_f + 4 * fq);
#pragma unroll
                    for (int e = 0; e < 4; ++e) v[e] = logsigmoidf(v[e] + b0[e]);
                    *(GAS1 f32x4*)((float*)(ws + WS_LOGF) + (size_t)row * 16 + 4 * fq) = v;
                    float* df = (row < MPROMPT) ? out + O_PLF + (size_t)row * 16 + 4 * fq : out + O_SLF + (size_t)(row - MPROMPT) * 16 + 4 * fq;
                    *(f32x4*)df = v;
                }
            }
        }
    }
};

template <class Epi, class Sched, bool ALIGN_EPI = false, bool SP2 = false>
__device__ __forceinline__ void gemm_phase(PG8_LAS unsigned char* lds, const Gemm g, const Sched& S, const Epi& E, const int tid) {
    const int wid = __builtin_amdgcn_readfirstlane(tid >> 6), lane = tid & 63, wr = wid >> 2, wc = wid & 3, fr = lane & 15, fq = lane >> 4;
    const int K = g.K, nt = K / BK;
    unsigned voffA[2], voffB[2];
#pragma unroll
    for (int i = 0; i < 2; ++i) { int R, C; stage_rc(tid * 16 + i * 8192, R, C); const int Rb = Epi::PERM ? ((R & ~31) + perm32(R & 31)) : R;
        voffA[i] = (unsigned)(R * g.lda + C) * 2u; voffB[i] = (unsigned)(Rb * K + C) * 2u; }
    const size_t kstep = (size_t)(BK * 2);
    const unsigned hstepB = (unsigned)HALF * K * 2, hstepA = (unsigned)HALF * g.lda * 2;
    const unsigned tstepB = 2 * hstepB, tstepA = 2 * hstepA;
    const unsigned ldsw = (unsigned)wid * 1024u;
    const int aoff = lds_byte(wr * 64 + fr, fq * 8), boff = lds_byte(wc * 32 + fr, fq * 8);
#define PG8_SA(b, h) (((b) * 2 + (h)) * HTB)
#define PG8_SB(b, h) ((4 + (b) * 2 + (h)) * HTB)
#define PG8_STAGE(bufoff, gbase, voff) do { _Pragma("unroll") for (int _i = 0; _i < 2; ++_i) \
        __builtin_amdgcn_global_load_lds((const unsigned*)((const char*)(gbase) + (voff)[_i]), (PG8_LAS unsigned*)(lds + (bufoff) + ldsw + _i * 8192), 16, 0, 0); } while (0)
#define PG8_LDA(dst, b, h) do { _Pragma("unroll") for (int m = 0; m < 4; ++m) _Pragma("unroll") for (int k = 0; k < 2; ++k) dst[m][k] = *(const PG8_LAS bf16x8*)(lds + PG8_SA(b, h) + aoff + m * 2048 + k * 1024); } while (0)
#define PG8_LDB(dst, b, h) do { _Pragma("unroll") for (int n = 0; n < 2; ++n) _Pragma("unroll") for (int k = 0; k < 2; ++k) dst[n][k] = *(const PG8_LAS bf16x8*)(lds + PG8_SB(b, h) + boff + n * 2048 + k * 1024); } while (0)
#define PG8_MMA(ai, bj, At, Bt) do { __builtin_amdgcn_s_setprio(1); _Pragma("unroll") for (int m = 0; m < 4; ++m) _Pragma("unroll") for (int n = 0; n < 2; ++n) _Pragma("unroll") for (int k = 0; k < 2; ++k) \
        acc[ai][bj][m][n] = __builtin_amdgcn_mfma_f32_16x16x32_bf16(Bt[n][k], At[m][k], acc[ai][bj][m][n], 0, 0, 0); __builtin_amdgcn_s_setprio(0); } while (0)
#define PG8_WAIT_V(n) asm volatile("s_waitcnt vmcnt(" #n ")" ::: "memory")
#define PG8_WAIT_L(n) asm volatile("s_waitcnt lgkmcnt(" #n ")" ::: "memory")
#define PG8_BAR __builtin_amdgcn_s_barrier()
#define PG8_SCHED __builtin_amdgcn_sched_barrier(0)
    Unit cur, nxt; int ui = 0;
    if (!S.next(0, cur)) return;
    f32x4 acc[2][2][4][2];
#pragma unroll
    for (int a = 0; a < 2; ++a)
#pragma unroll
        for (int b = 0; b < 2; ++b)
#pragma unroll
            for (int m = 0; m < 4; ++m)
#pragma unroll
                for (int n = 0; n < 2; ++n) acc[a][b][m][n] = (f32x4){0.f, 0.f, 0.f, 0.f};
    bf16x8 At[4][2], B0[2][2], B1[2][2];
    const char* cA = (const char*)g.A + (size_t)cur.pm * tstepA; const char* cB = (const char*)g.Bt + (size_t)cur.pn * tstepB;
    S.a_ready(cur);
    if constexpr (SP2) {
        PG8_STAGE(PG8_SB(0, 0), cB, voffB); PG8_STAGE(PG8_SB(0, 1), cB + hstepB, voffB); PG8_STAGE(PG8_SA(0, 0), cA, voffA); PG8_STAGE(PG8_SA(0, 1), cA + hstepA, voffA);
        if (wr == 1) PG8_BAR;
        PG8_WAIT_V(2); PG8_BAR;
        PG8_STAGE(PG8_SB(1, 0), cB + kstep, voffB); PG8_STAGE(PG8_SA(1, 0), cA + kstep, voffA); PG8_STAGE(PG8_SB(1, 1), cB + hstepB + kstep, voffB);
        PG8_WAIT_V(6); PG8_BAR;
    } else {
        PG8_STAGE(PG8_SB(0, 0), cB, voffB); PG8_STAGE(PG8_SA(0, 0), cA, voffA); PG8_STAGE(PG8_SB(0, 1), cB + hstepB, voffB); PG8_STAGE(PG8_SA(0, 1), cA + hstepA, voffA);
        if (wr == 1) PG8_BAR;
        PG8_WAIT_V(4); PG8_BAR;
        PG8_STAGE(PG8_SB(1, 0), cB + kstep, voffB); PG8_STAGE(PG8_SA(1, 0), cA + kstep, voffA); PG8_STAGE(PG8_SB(1, 1), cB + hstepB + kstep, voffB);
        PG8_WAIT_V(6); PG8_BAR;
    }
    for (;;) {
        const bool has_next = S.next(ui + 1, nxt);
        const char* nA = has_next ? (const char*)g.A + (size_t)nxt.pm * tstepA : cA; const char* nB = has_next ? (const char*)g.Bt + (size_t)nxt.pn * tstepB : cB;
        for (int t = 0; t < nt; t += 2) {
            const bool last = (t == nt - 2);
            const char* a1 = cA + (unsigned)(t >> 1) * (unsigned)g.apair + 128u;
            const char* a2 = last ? nA : cA + (unsigned)((t >> 1) + 1) * (unsigned)g.apair; const char* b2 = last ? nB : cB + (size_t)(t + 2) * kstep;
            const char* a3 = a2 + kstep; const char* b3 = b2 + kstep;
            if (last && has_next) S.a_ready(nxt);
            if constexpr (SP2) {
            PG8_LDB(B0, 0, 0); PG8_LDB(B1, 0, 1); PG8_SCHED; PG8_LDA(At, 0, 0); PG8_STAGE(PG8_SA(1, 1), a1 + hstepA, voffA);
            PG8_WAIT_V(8); PG8_WAIT_L(0); PG8_BAR; PG8_MMA(0, 0, At, B0); PG8_MMA(0, 1, At, B1); PG8_BAR; PG8_SCHED;
            PG8_LDA(At, 0, 1); PG8_STAGE(PG8_SB(0, 0), b2, voffB); PG8_STAGE(PG8_SB(0, 1), b2 + hstepB, voffB); PG8_STAGE(PG8_SA(0, 0), a2, voffA);
            PG8_WAIT_V(8); PG8_WAIT_L(0); PG8_BAR; PG8_MMA(1, 0, At, B0); PG8_MMA(1, 1, At, B1); PG8_BAR; PG8_SCHED;
            PG8_LDB(B0, 1, 0); PG8_LDB(B1, 1, 1); PG8_SCHED; PG8_LDA(At, 1, 0); PG8_STAGE(PG8_SA(0, 1), a2 + hstepA, voffA);
            PG8_WAIT_V(8); PG8_WAIT_L(0); PG8_BAR; PG8_MMA(0, 0, At, B0); PG8_MMA(0, 1, At, B1); PG8_BAR; PG8_SCHED;
            PG8_LDA(At, 1, 1); PG8_STAGE(PG8_SB(1, 0), b3, voffB); PG8_STAGE(PG8_SB(1, 1), b3 + hstepB, voffB); PG8_STAGE(PG8_SA(1, 0), a3, voffA);
            PG8_WAIT_V(8); PG8_WAIT_L(0); PG8_BAR; PG8_MMA(1, 0, At, B0); PG8_MMA(1, 1, At, B1); PG8_BAR; PG8_SCHED;
            } else {
            PG8_LDB(B0, 0, 0); PG8_SCHED; PG8_LDA(At, 0, 0); PG8_STAGE(PG8_SA(1, 1), a1 + hstepA, voffA);
            PG8_WAIT_L(8); PG8_BAR; PG8_WAIT_L(0); PG8_MMA(0, 0, At, B0); PG8_BAR; PG8_SCHED;
            PG8_LDB(B1, 0, 1); PG8_STAGE(PG8_SB(0, 0), b2, voffB);
            PG8_BAR; PG8_WAIT_L(0); PG8_MMA(0, 1, At, B1); PG8_BAR;
            PG8_LDA(At, 0, 1); PG8_STAGE(PG8_SA(0, 0), a2, voffA);
            PG8_BAR; PG8_WAIT_L(0); PG8_MMA(1, 0, At, B0); PG8_BAR; PG8_SCHED;
            PG8_STAGE(PG8_SB(0, 1), b2 + hstepB, voffB);
            PG8_WAIT_V(6); PG8_BAR; PG8_MMA(1, 1, At, B1); PG8_BAR;
            PG8_LDB(B0, 1, 0); PG8_SCHED; PG8_LDA(At, 1, 0); PG8_STAGE(PG8_SA(0, 1), a2 + hstepA, voffA);
            PG8_WAIT_L(8); PG8_BAR; PG8_WAIT_L(0); PG8_MMA(0, 0, At, B0); PG8_BAR; PG8_SCHED;
            PG8_LDB(B1, 1, 1); PG8_STAGE(PG8_SB(1, 0), b3, voffB);
            PG8_BAR; PG8_WAIT_L(0); PG8_MMA(0, 1, At, B1); PG8_BAR;
            PG8_LDA(At, 1, 1); PG8_STAGE(PG8_SA(1, 0), a3, voffA);
            PG8_BAR; PG8_WAIT_L(0); PG8_MMA(1, 0, At, B0); PG8_BAR; PG8_SCHED;
            PG8_STAGE(PG8_SB(1, 1), b3 + hstepB, voffB);
            PG8_WAIT_V(6); PG8_BAR; PG8_MMA(1, 1, At, B1); PG8_BAR;
            }
        }
        if constexpr (ALIGN_EPI) { if (wr == 0) PG8_BAR; }
        if constexpr (!Epi::AFTER_DRAIN) { E(acc, cur, wr, wc, fr, fq); S.done(cur); }
        if (!has_next) break;
#pragma unroll
        for (int a = 0; a < 2; ++a)
#pragma unroll
            for (int b = 0; b < 2; ++b)
#pragma unroll
                for (int m = 0; m < 4; ++m)
#pragma unroll
                    for (int n = 0; n < 2; ++n) acc[a][b][m][n] = (f32x4){0.f, 0.f, 0.f, 0.f};
        cur = nxt; cA = nA; cB = nB; ++ui;
        if constexpr (ALIGN_EPI) { if (wr == 1) PG8_BAR; }
    }
    PG8_WAIT_V(0);
    if constexpr (!ALIGN_EPI) { if (wr == 0) PG8_BAR; }
    PG8_BAR;
    if constexpr (Epi::AFTER_DRAIN) { E.fused(acc, cur, wr, wc, fr, fq, lds, wid, lane); S.done(cur); }
#undef PG8_SA
#undef PG8_SB
#undef PG8_STAGE
#undef PG8_LDA
#undef PG8_LDB
#undef PG8_MMA
#undef PG8_WAIT_V
#undef PG8_WAIT_L
#undef PG8_BAR
#undef PG8_SCHED
}
}
namespace pg8 {
constexpr int SM_STAGE = 40960;
template <class Epi>
__device__ __forceinline__ void gemm_small(PG8_LAS unsigned char* lds, const Gemm g, const int row_base, const int n_rt, const int vcu, const int G, const Epi& E, const int tid) {
    const int wid = __builtin_amdgcn_readfirstlane(tid >> 6), lane = tid & 63, fr = lane & 15, fq = lane >> 4;
    const int K = g.K, nt = K / BK, nN = g.N / BM;
    int R0, C0, R1, C1; stage_rc(tid * 16, R0, C0); stage_rc(tid * 16 + 8192, R1, C1);
    const unsigned voffA = (unsigned)(R0 * g.lda + C0) * 2u, voffB0 = (unsigned)(R0 * K + C0) * 2u, voffB1 = (unsigned)(R1 * K + C1) * 2u;
    const unsigned hB = (unsigned)HALF * K * 2u, ldsw = (unsigned)wid * 1024u;
    const int aoff = lds_byte(fr, fq * 8), boff = 8192 + lds_byte(wid * 16 + fr, fq * 8);
#define SM_GLDS(src, dst) __builtin_amdgcn_global_load_lds((const unsigned*)(src), (PG8_LAS unsigned*)(dst), 16, 0, 0)
#define SM_STAGE_TILE(t, s) do { const char* a_ = pA + (unsigned)((t) >> 1) * (unsigned)g.apair + (unsigned)((t) & 1) * 128u; const char* b_ = pB + (unsigned)(t) * 128u; PG8_LAS unsigned char* d_ = lds + (s) * SM_STAGE + ldsw; \
        SM_GLDS(a_ + voffA, d_); SM_GLDS(b_ + voffB0, d_ + 8192); SM_GLDS(b_ + voffB1, d_ + 16384); SM_GLDS(b_ + hB + voffB0, d_ + 24576); SM_GLDS(b_ + hB + voffB1, d_ + 32768); } while (0)
    for (int u = vcu; u < n_rt * nN; u += G) {
        const int pn = u / n_rt, rt = u % n_rt;
        const char* pA = (const char*)g.A + (size_t)(row_base + 64 * rt) * g.lda * 2;
        const char* pB = (const char*)g.Bt + (size_t)(256 * pn) * K * 2;
        f32x4 acc[2][4];
#pragma unroll
        for (int b = 0; b < 2; ++b)
#pragma unroll
            for (int m = 0; m < 4; ++m) acc[b][m] = (f32x4){0.f, 0.f, 0.f, 0.f};
        SM_STAGE_TILE(0, 0); SM_STAGE_TILE(1, 1);
        int s = 0, s2 = 2;
#pragma unroll 1
        for (int t = 0; t < nt; ++t) {
            if (t + 1 < nt) asm volatile("s_waitcnt vmcnt(5)" ::: "memory"); else asm volatile("s_waitcnt vmcnt(0)" ::: "memory");
            asm volatile("s_waitcnt lgkmcnt(0)" ::: "memory"); __builtin_amdgcn_s_barrier(); asm volatile("" ::: "memory");
            if (t + 2 < nt) SM_STAGE_TILE(t + 2, s2);
            bf16x8 Af[4][2], Bf[2][2];
            PG8_LAS unsigned char* sb = lds + s * SM_STAGE;
#pragma unroll
            for (int m = 0; m < 4; ++m)
#pragma unroll
                for (int k = 0; k < 2; ++k) Af[m][k] = *(const PG8_LAS bf16x8*)(sb + aoff + m * 2048 + k * 1024);
#pragma unroll
            for (int b = 0; b < 2; ++b)
#pragma unroll
                for (int k = 0; k < 2; ++k) Bf[b][k] = *(const PG8_LAS bf16x8*)(sb + boff + b * 16384 + k * 1024);
#pragma unroll
            for (int k = 0; k < 2; ++k)
#pragma unroll
                for (int b = 0; b < 2; ++b)
#pragma unroll
                    for (int m = 0; m < 4; ++m) acc[b][m] = __builtin_amdgcn_mfma_f32_16x16x32_bf16(Bf[b][k], Af[m][k], acc[b][m], 0, 0, 0);
            s = (s == 2) ? 0 : s + 1; s2 = (s2 == 2) ? 0 : s2 + 1;
        }
        asm volatile("s_waitcnt lgkmcnt(0)" ::: "memory"); __builtin_amdgcn_s_barrier(); asm volatile("" ::: "memory");
        E.small(acc, row_base + 64 * rt, pn, wid, fr, fq);
    }
#undef SM_GLDS
#undef SM_STAGE_TILE
}

constexpr int S64_STAGE = 16384, S64_NST = 7, S64_SCR = S64_STAGE * S64_NST;
__device__ __forceinline__ void gemm_small64_resid(PG8_LAS unsigned char* lds, const Gemm g, const int row_base, const int vcu, const int G, unsigned char* ws, const int sel, const int tid, const bool nop) {
    const int wid = __builtin_amdgcn_readfirstlane(tid >> 6), lane = tid & 63, fr = lane & 15, fq = lane >> 4, wr = wid >> 2, wc = wid & 3;
    const int K = g.K, nt = K / BK, nN = g.N / 64, n_rt = 16;
    int R0, C0; stage_rc(tid * 16, R0, C0);
    const unsigned voffA = (unsigned)(R0 * g.lda + C0) * 2u, voffB = (unsigned)(R0 * K + C0) * 2u, ldsw = (unsigned)wid * 1024u;
    const int aoff = lds_byte(32 * wr + fr, fq * 8), boff = 8192 + lds_byte(16 * wc + fr, fq * 8);
#define S64_GLDS(src, dst) __builtin_amdgcn_global_load_lds((const unsigned*)(src), (PG8_LAS unsigned*)(dst), 16, 0, 0)
#define S64_STAGE_TILE(t, s) do { const char* a_ = pA + (unsigned)((t) >> 1) * (unsigned)g.apair + (unsigned)((t) & 1) * 128u; const char* b_ = pB + (unsigned)(t) * 128u; PG8_LAS unsigned char* d_ = lds + (s) * S64_STAGE + ldsw; \
        S64_GLDS(a_ + voffA, d_); S64_GLDS(b_ + voffB, d_ + 8192); } while (0)
    for (int u = vcu; u < n_rt * nN; u += G) {
        const int pn = u / n_rt, rt = u % n_rt, row0 = row_base + 64 * rt;
        const char* pA = (const char*)g.A + (size_t)row0 * g.lda * 2;
        const char* pB = (const char*)g.Bt + (size_t)(64 * pn) * K * 2;
        f32x4 acc[2]; acc[0] = (f32x4){0.f, 0.f, 0.f, 0.f}; acc[1] = (f32x4){0.f, 0.f, 0.f, 0.f};
#pragma unroll
        for (int t = 0; t < S64_NST - 1; ++t) S64_STAGE_TILE(t, t);
        int s = 0, s2 = S64_NST - 1;
#pragma unroll 1
        for (int t = 0; t < nt; ++t) {
            const int rem = nt - 1 - t;
            if (rem >= 5) asm volatile("s_waitcnt vmcnt(10)" ::: "memory"); else if (rem == 4) asm volatile("s_waitcnt vmcnt(8)" ::: "memory"); else if (rem == 3) asm volatile("s_waitcnt vmcnt(6)" ::: "memory");
            else if (rem == 2) asm volatile("s_waitcnt vmcnt(4)" ::: "memory"); else if (rem == 1) asm volatile("s_waitcnt vmcnt(2)" ::: "memory"); else asm volatile("s_waitcnt vmcnt(0)" ::: "memory");
            asm volatile("s_waitcnt lgkmcnt(0)" ::: "memory"); __builtin_amdgcn_s_barrier(); asm volatile("" ::: "memory");
            if (t + S64_NST - 1 < nt) S64_STAGE_TILE(t + S64_NST - 1, s2);
            PG8_LAS unsigned char* sb = lds + s * S64_STAGE;
            bf16x8 Af[2][2], Bf[2];
#pragma unroll
            for (int m = 0; m < 2; ++m)
#pragma unroll
                for (int k = 0; k < 2; ++k) Af[m][k] = *(const PG8_LAS bf16x8*)(sb + aoff + m * 2048 + k * 1024);
#pragma unroll
            for (int k = 0; k < 2; ++k) Bf[k] = *(const PG8_LAS bf16x8*)(sb + boff + k * 1024);
#pragma unroll
            for (int k = 0; k < 2; ++k)
#pragma unroll
                for (int m = 0; m < 2; ++m) acc[m] = __builtin_amdgcn_mfma_f32_16x16x32_bf16(Bf[k], Af[m][k], acc[m], 0, 0, 0);
            s = (s == S64_NST - 1) ? 0 : s + 1; s2 = (s2 == S64_NST - 1) ? 0 : s2 + 1;
        }
        if (nop) { asm volatile("" :: "v"(acc[0]), "v"(acc[1])); asm volatile("s_waitcnt lgkmcnt(0)" ::: "memory"); __builtin_amdgcn_s_barrier(); continue; }
        PG8_LAS float* scr = (PG8_LAS float*)(lds + S64_SCR);
        bf16_t* X = (bf16_t*)(ws + WS_X); GAS1 float* ssq_out = (GAS1 float*)(ws + WS_SSQ0 + (size_t)sel * SSQ_BYTES);
        u32x2 old2[2];
#pragma unroll
        for (int m = 0; m < 2; ++m) old2[m] = *(const GAS1 u32x2*)(X + (size_t)(row0 + 32 * wr + 16 * m + fr) * 1024 + 64 * pn + 16 * wc + 4 * fq);
#pragma unroll
        for (int m = 0; m < 2; ++m) {
            const int rl = 32 * wr + 16 * m + fr, row = row0 + rl;
            bf16_t* p = X + (size_t)row * 1024 + 64 * pn + 16 * wc + 4 * fq;
            const u32x2 o = old2[m]; f32x4 r;
            r[0] = __uint_as_float(o.x << 16); r[1] = __uint_as_float(o.x & 0xffff0000u); r[2] = __uint_as_float(o.y << 16); r[3] = __uint_as_float(o.y & 0xffff0000u);
            const f32x4 v = acc[m] + r;
            float ss = (v[0] * v[0] + v[1] * v[1]) + (v[2] * v[2] + v[3] * v[3]);
            *(u32x2*)p = pack4(v);
            ss += __shfl_xor(ss, 16); ss += __shfl_xor(ss, 32);
            if (fq == 0) scr[rl * 4 + wc] = ss;
        }
        asm volatile("s_waitcnt lgkmcnt(0)" ::: "memory"); __builtin_amdgcn_s_barrier(); asm volatile("" ::: "memory");
        if (tid < 128) { const int rl = tid >> 1, hf = tid & 1; ssq_out[(size_t)(row0 + rl) * SSQ_SLOTS + pn * 2 + hf] = scr[rl * 4 + 2 * hf] + scr[rl * 4 + 2 * hf + 1]; }
    }
#undef S64_GLDS
#undef S64_STAGE_TILE
}
}

#define PG8_SP2 true
#define PG8_ALIGN true
#define ATTN_STORE16(p,v) (*(__attribute__((address_space(1))) attn_u32x4_t*)(p)=(v))
typedef unsigned attn_u32x4_t __attribute__((ext_vector_type(4)));
#include <hip/hip_bf16.h>
#include <cmath>
namespace attn_body {
using bf16=__hip_bfloat16;
using bf16x8=__attribute__((ext_vector_type(8)))short;
using s16x4=__attribute__((ext_vector_type(4)))short;
using f32x16=__attribute__((ext_vector_type(16)))float;
using u32x4=__attribute__((ext_vector_type(4)))unsigned;
using f32x4_t=__attribute__((ext_vector_type(4)))float;
constexpr int BATCH=4,NHEAD=16,SEQ=8192,D=64,DM=NHEAD*D;
constexpr int NW=8,QBLK=32,QB=QBLK*NW,KVBLK=64,NQB=SEQ/QB;
constexpr int ATTN_PITCH=DM, ATTN_UNIT_ROWS=QB;
__device__ __forceinline__ int crow(int r,int hi){return (r&3)+8*(r>>2)+4*hi;}
#define SBAR() __builtin_amdgcn_sched_barrier(0)
__device__ __forceinline__ void cmask(f32x16&p0,f32x16&p1,int jb,int qrel,int hi){
  const float NEG=-INFINITY; int kb=64*jb+4*hi;
  #pragma unroll
  for(int r=0;r<16;++r){int kv=kb+(r&3)+8*(r>>2); if(kv>qrel)p0[r]=NEG; if(kv+32>qrel)p1[r]=NEG;}
}

constexpr int NSLOT=3, SLOTB=8192;
constexpr int LDS_K=0, LDS_V=NSLOT*SLOTB, LDS_WS=2*NSLOT*SLOTB, LDS_OST=LDS_WS+NW*64*4, LDS_BIAS=LDS_OST+NW*4096, LDS_BYTES=LDS_BIAS+SEQ*4;
constexpr float C2=0.125f*1.4426950408889634f;
__device__ __forceinline__ void glds16(const void*gsrc,unsigned lds_dst){unsigned keep;
  asm volatile("s_mov_b32 %0, m0\n\ts_mov_b32 m0, %2\n\ts_nop 0\n\tglobal_load_lds_dwordx4 %1, off\n\ts_mov_b32 m0, %0":"=&s"(keep):"v"(gsrc),"s"(lds_dst):"memory");}
__device__ __forceinline__ float max3f(float a,float b,float c){float r;asm("v_max3_f32 %0, %1, %2, %3":"=v"(r):"v"(a),"v"(b),"v"(c));return r;}
__device__ __forceinline__ float max2f(float a,float b){float r;asm("v_max_f32_e32 %0, %1, %2":"=v"(r):"v"(a),"v"(b));return r;}
__device__ __forceinline__ float fadd_s(float a,float b){float r;asm("v_add_f32_e32 %0, %1, %2":"=v"(r):"v"(a),"v"(b));return r;}
__device__ __forceinline__ float fsub_s(float a,float b){float r;asm("v_sub_f32_e32 %0, %1, %2":"=v"(r):"v"(a),"v"(b));return r;}
typedef float f32x2_t __attribute__((ext_vector_type(2))); typedef __bf16 bf16x2_t __attribute__((ext_vector_type(2)));
__device__ __forceinline__ unsigned cvtpk_s(float lo,float hi){f32x2_t v={lo,hi};bf16x2_t b=__builtin_convertvector(v,bf16x2_t);return __builtin_bit_cast(unsigned,b);}
#define WAIT_BAR(N) asm volatile("s_waitcnt vmcnt(" #N ") lgkmcnt(0)\n\ts_barrier":::"memory")

__device__ __forceinline__ void qkt(f32x16&p0,f32x16&p1,const char*Kslot,const bf16x8*qr,int r32,int hi,const bf16x8 ab0,const bf16x8 ab1,const bf16x8 qb){
  p0=__builtin_amdgcn_mfma_f32_32x32x16_bf16(ab0,qb,f32x16{},0,0,0);p1=__builtin_amdgcn_mfma_f32_32x32x16_bf16(ab1,qb,f32x16{},0,0,0);
  const char*kb=Kslot+hi*1024+r32*16;
  #pragma unroll
  for(int d0=0;d0<4;++d0){
    const bf16x8 b0=*reinterpret_cast<const bf16x8*>(kb+d0*2048);
    const bf16x8 b1=*reinterpret_cast<const bf16x8*>(kb+d0*2048+512);
    {p0=__builtin_amdgcn_mfma_f32_32x32x16_bf16(b0,qr[d0],p0,0,0,0);p1=__builtin_amdgcn_mfma_f32_32x32x16_bf16(b1,qr[d0],p1,0,0,0);}}
}
typedef __attribute__((address_space(3))) const char* lds_cptr;
typedef short v4i16_t __attribute__((ext_vector_type(4)));
__device__ __forceinline__ void kload8(bf16x8*kf,lds_cptr kp){
  kf[0]=*(const __attribute__((address_space(3))) bf16x8*)(kp);      kf[1]=*(const __attribute__((address_space(3))) bf16x8*)(kp+512);
  kf[2]=*(const __attribute__((address_space(3))) bf16x8*)(kp+2048); kf[3]=*(const __attribute__((address_space(3))) bf16x8*)(kp+2560);
  kf[4]=*(const __attribute__((address_space(3))) bf16x8*)(kp+4096); kf[5]=*(const __attribute__((address_space(3))) bf16x8*)(kp+4608);
  kf[6]=*(const __attribute__((address_space(3))) bf16x8*)(kp+6144); kf[7]=*(const __attribute__((address_space(3))) bf16x8*)(kp+6656);
}
__device__ __forceinline__ void kload2(bf16x8*kf,lds_cptr kp,int j){ kf[2*j]=*(const __attribute__((address_space(3))) bf16x8*)(kp+j*2048); kf[2*j+1]=*(const __attribute__((address_space(3))) bf16x8*)(kp+j*2048+512); }
__device__ __forceinline__ s16x4 vtr(lds_cptr p){ return __builtin_bit_cast(s16x4,__builtin_amdgcn_ds_read_tr16_b64_v4i16((__attribute__((address_space(3))) v4i16_t*)p)); }
__device__ __forceinline__ float rowmax(const f32x16&p0,const f32x16&p1){
  float a=max3f(p0[0],p0[1],p1[0]),b=max3f(p0[2],p0[3],p1[1]);a=max3f(a,p1[2],p1[3]);
  #pragma unroll
  for(int r=4;r<16;r+=4){a=max3f(a,p0[r],p0[r+1]);b=max3f(b,p0[r+2],p0[r+3]);a=max3f(a,p1[r],p1[r+1]);b=max3f(b,p1[r+2],p1[r+3]);}
  const float m=max2f(a,b);
  auto rr=__builtin_amdgcn_permlane32_swap(__float_as_uint(m),__float_as_uint(m),false,false);
  return max2f(__uint_as_float(rr[0]),__uint_as_float(rr[1]));
}
__device__ __forceinline__ void pv(f32x16*o,int vb,bf16x8 pa0,bf16x8 pa1,bf16x8 pa2,bf16x8 pa3){
  #pragma unroll
  for(int d0=0;d0<2;++d0){s16x4 lo[4],hi[4];
    #pragma unroll
    for(int ks=0;ks<4;++ks){
      asm volatile("ds_read_b64_tr_b16 %0,%1 offset:%c2":"=&v"(lo[ks]):"v"(vb),"i"(d0*4096+ks*1024):"memory");
      asm volatile("ds_read_b64_tr_b16 %0,%1 offset:%c2":"=&v"(hi[ks]):"v"(vb),"i"(d0*4096+ks*1024+512):"memory");}
    asm volatile("s_waitcnt lgkmcnt(0)":::"memory");SBAR();
    #define PK(k) (bf16x8){lo[k][0],lo[k][1],lo[k][2],lo[k][3],hi[k][0],hi[k][1],hi[k][2],hi[k][3]}
    o[d0]=__builtin_amdgcn_mfma_f32_32x32x16_bf16(pa0,PK(0),o[d0],0,0,0);
    o[d0]=__builtin_amdgcn_mfma_f32_32x32x16_bf16(pa1,PK(1),o[d0],0,0,0);
    o[d0]=__builtin_amdgcn_mfma_f32_32x32x16_bf16(pa2,PK(2),o[d0],0,0,0);
    o[d0]=__builtin_amdgcn_mfma_f32_32x32x16_bf16(pa3,PK(3),o[d0],0,0,0);
    #undef PK
  }
}

#ifndef ATTN_STORE16
#define ATTN_STORE16(p,v) (*(u32x4*)(p)=(v))
#endif
template<int THRL> __device__ __forceinline__ void attn_unit(int b,int h,int qb,const bf16*Q,const bf16*__restrict__ K,const bf16*__restrict__ V,bf16*O,const float*__restrict__ CSl,const float*__restrict__ TOTl,char*shm,const int tid_in){
  int tidu_=tid_in; asm volatile("":"+v"(tidu_)); const int tid=tidu_;
  const int lane=tid&63,r32=lane&31,hi=lane>>5; const int wid=__builtin_amdgcn_readfirstlane(tid>>6);
  const long rowbase=(long)b*SEQ; const int q0=qb*QB;
  const bf16*Qw=Q+(rowbase+q0+wid*QBLK)*DM+h*D;
  const bf16*Kh=K+rowbase*DM+h*D,*Vh=V+rowbase*DM+h*D;
  const unsigned lds0=(unsigned)(uintptr_t)shm;
  float*wsf=(float*)(shm+LDS_WS)+wid*64;
  {
    typedef __attribute__((address_space(3))) f32x4_t lf4;
    const int bh_=b*NHEAD+h; int tidl_=tid; asm volatile("":"+v"(tidl_));
    const f32x4_t*c4=(const f32x4_t*)(CSl+(long)bh_*SEQ); lf4*bl=(lf4*)((__attribute__((address_space(3))) char*)shm+LDS_BIAS);
    const int n4=(q0+QB)/4;
    { f32x4_t cq_[4];
      #pragma unroll
      for(int j_=0;j_<4;++j_){ const int i4=tidl_+j_*NW*64; cq_[j_]=(i4<n4)?c4[i4]:f32x4_t{0.f,0.f,0.f,0.f}; }
      #pragma unroll
      for(int j_=0;j_<4;++j_){ const int i4=tidl_+j_*NW*64; if(i4<n4)bl[i4]=cq_[j_]; } }
    asm volatile("s_waitcnt lgkmcnt(0)":::"memory");
  }
  const bf16*ksrc=Kh+(long)lane*DM+wid*8;
  const bf16*vsrc=Vh+(long)(16*(wid&3)+(lane>>2))*DM+(wid>>2)*32+(lane&3)*8;
  const unsigned kdst=lds0+LDS_K+wid*1024, vdst=lds0+LDS_V+wid*1024;
  #define DMA_K(t,slot) glds16(ksrc+(long)(t)*KVBLK*DM,(unsigned)__builtin_amdgcn_readfirstlane(kdst+(slot)))
  #define DMA_V(t,slot) glds16(vsrc+(long)(t)*KVBLK*DM,(unsigned)__builtin_amdgcn_readfirstlane(vdst+(slot)))
  const int vb0=(int)(lds0+LDS_V)+((lane>>4)&1)*32+(lane&3)*8+(4*hi+((lane&15)>>2))*64;
  const char*Kbase=shm+LDS_K; bf16x8 kf[8];
  const lds_cptr shm3=(lds_cptr)shm; const lds_cptr kp0=shm3+LDS_K+hi*1024+r32*16; const lds_cptr vp0=shm3+LDS_V+((lane>>4)&1)*32+(lane&3)*8+(4*hi+((lane&15)>>2))*64;
  const int NT=(q0+QB)/KVBLK;
  DMA_K(0,0);DMA_V(0,0);DMA_K(1,SLOTB);
  bf16x8 qr[4];
  #pragma unroll
  for(int d0=0;d0<4;++d0)qr[d0]=*reinterpret_cast<const bf16x8*>(&Qw[(long)r32*DM+d0*16+hi*8]);
  float mhat=0.f,l_reg=0.f;f32x16 o[2];o[0]=f32x16{};o[1]=f32x16{};
  const unsigned hmsk_=hi?0u:0xFFFFFFFFu;
  u32x4 qb_, abA0, abA1; asm volatile("":"=v"(qb_),"=v"(abA0),"=v"(abA1));
  #define MHSPLIT() do{ const unsigned mb_=__float_as_uint(mhat); const float r1_=mhat-__uint_as_float(mb_&0xFFFF0000u); const unsigned rb_=__float_as_uint(r1_); const float r2_=r1_-__uint_as_float(rb_&0xFFFF0000u); \
    qb_.x=0x3F803F80u&hmsk_; qb_.y=(0x3F80u|(mb_&0xFFFF0000u))&hmsk_; qb_.z=((rb_>>16)|(__float_as_uint(r2_)&0xFFFF0000u))&hmsk_; qb_.w=0u; asm volatile("":"+v"(qb_)); }while(0)
  #define BFRAG(AB,bv) do{ const unsigned bb_=__float_as_uint(bv); const float r1_=(bv)-__uint_as_float(bb_&0xFFFF0000u); const unsigned rb_=__float_as_uint(r1_); const float r2_=r1_-__uint_as_float(rb_&0xFFFF0000u); \
    AB.x=((bb_>>16)|(rb_&0xFFFF0000u))&hmsk_; AB.y=((__float_as_uint(r2_)>>16)|0xBF800000u)&hmsk_; AB.z=0xBF80BF80u&hmsk_; AB.w=0u; }while(0)
  #define LOADBF(AB0,AB1,tt) do{ const __attribute__((address_space(3))) float*bp_=(const __attribute__((address_space(3))) float*)(shm3+LDS_BIAS)+(tt)*64+r32; const float b0_=bp_[0],b1_=bp_[32]; BFRAG(AB0,b0_); BFRAG(AB1,b1_); asm volatile("":"+v"(AB0),"+v"(AB1)); }while(0)
  #define LOADBR(tt) do{ const __attribute__((address_space(3))) float*bp_=(const __attribute__((address_space(3))) float*)(shm3+LDS_BIAS)+(tt)*64+r32; braw0_=bp_[0]; braw1_=bp_[32]; }while(0)
  #define MAKEBF(AB0,AB1) do{ BFRAG(AB0,braw0_); BFRAG(AB1,braw1_); asm volatile("":"+v"(AB0),"+v"(AB1)); }while(0)
  #define BF8(x) __builtin_bit_cast(bf16x8,x)
  const int qrel=wid*QBLK+r32;
  #define CMASK(P0,P1,t) do{int jb_=(t)-(NT-4); if(jb_>=0)cmask(P0,P1,jb_,qrel,hi);}while(0)
  bool resc=false;
  #define START(P0,P1) do{ const float rm=rowmax(P0,P1); resc=false; \
    { const float dl=rm; mhat=fadd_s(mhat,dl); \
      _Pragma("unroll") for(int r=0;r<16;++r){P0[r]=fsub_s(P0[r],dl);P1[r]=fsub_s(P1[r],dl);} } \
    _Pragma("unroll") for(int r=0;r<16;++r)P0[r]=__builtin_amdgcn_exp2f(P0[r]); }while(0)
  #define RESC() do{ if(resc){ asm volatile("s_waitcnt lgkmcnt(0)":::"memory"); \
      _Pragma("unroll") for(int d_=0;d_<2;++d_) _Pragma("unroll") for(int r=0;r<16;++r)o[d_][r]*=wsf[crow(r,hi)]; } }while(0)
  f32x16 pA0,pA1,pB0,pB1;
  int sl_prev=0,sl_cur=0,sl_next=SLOTB;
  #define ROT() do{sl_prev=sl_cur;sl_cur=sl_next;sl_next=(sl_next==(NSLOT-1)*SLOTB)?0:sl_next+SLOTB;}while(0)
  DMA_K(2,2*SLOTB);
  WAIT_BAR(3);
  LOADBF(abA0,abA1,0); MHSPLIT(); qkt(pA0,pA1,Kbase,qr,r32,hi,BF8(abA0),BF8(abA1),BF8(qb_));asm volatile("s_nop 15\n\ts_nop 7":"+v"(pA0),"+v"(pA1));CMASK(pA0,pA1,0);
  START(pA0,pA1);
  _Pragma("unroll") for(int r=0;r<16;++r)pA1[r]=__builtin_amdgcn_exp2f(pA1[r]);
  MHSPLIT(); LOADBF(abA0,abA1,1);
  WAIT_BAR(0);
  DMA_K(3,0);DMA_V(1,SLOTB);
  ROT();
  kload8(kf,kp0+sl_cur);
  WAIT_BAR(2);
  s16x4 vlo[8],vhi[8]; u32x4 pw0,pw1,pw2,pw3; asm volatile("":"=v"(pw0),"=v"(pw1),"=v"(pw2),"=v"(pw3));
  #define PKW(P,B) cvtpk_s(P[B],P[B+1])
  #define PAF(k) __builtin_bit_cast(bf16x8,pw##k)
  #define VFR(i) (bf16x8){vlo[i][0],vlo[i][1],vlo[i][2],vlo[i][3],vhi[i][0],vhi[i][1],vhi[i][2],vhi[i][3]}
  #define PIN(x) asm volatile("":"+v"(x))
  #define MX3(a,b,c) __builtin_fmaxf(__builtin_fmaxf((a),(b)),(c))
  #define GAPA(MF,A0,A1,A2,A3,W0,W1,PW) do{ MF; sacc+=A0; sacc+=A1; sacc+=A2; sacc+=A3; PIN(sacc); W0; W1; PIN(PW); SBAR(); }while(0)
  #define EX(v) __builtin_amdgcn_exp2f(v)
  #define GAPB(MF,X,B) do{ MF; X[B]=EX(X[B]); X[B+1]=EX(X[B+1]); X[B+2]=EX(X[B+2]); X[B+3]=EX(X[B+3]); PIN(X); SBAR(); }while(0)
  #define VRD(i) do{ vlo[i]=vtr(vp_+(((i)>>2)*4096+((i)&3)*1024)); vhi[i]=vtr(vp_+(((i)>>2)*4096+((i)&3)*1024+512)); }while(0)
  #define KRD(G,j) do{ if(G){ kload2(kf,kp0+sl_next,j); SBAR(); } }while(0)
  #define STEP(C0,C1,P0,P1,t,GK,GV,GL,AB0,AB1,NB0,NB1) do{ SBAR(); \
    C0=__builtin_amdgcn_mfma_f32_32x32x16_bf16(BF8(AB0),BF8(qb_),f32x16{},0,0,0); C1=__builtin_amdgcn_mfma_f32_32x32x16_bf16(BF8(AB1),BF8(qb_),f32x16{},0,0,0); SBAR(); \
    const lds_cptr vp_=vp0+sl_prev; \
    VRD(0); SBAR(); float sacc=(P0[0]+P0[1]); \
    GAPA(C0=__builtin_amdgcn_mfma_f32_32x32x16_bf16(kf[0],qr[0],C0,0,0,0), P0[2],P0[3],P0[4],P0[5],     pw0[0]=PKW(P0,0), pw0[1]=PKW(P0,2), pw0); \
    VRD(4); SBAR(); GAPA(C1=__builtin_amdgcn_mfma_f32_32x32x16_bf16(kf[1],qr[0],C1,0,0,0), P0[6],P0[7],P0[8],P0[9],     pw0[2]=PKW(P0,4), pw0[3]=PKW(P0,6), pw0); \
    VRD(1); SBAR(); GAPA(C0=__builtin_amdgcn_mfma_f32_32x32x16_bf16(kf[2],qr[1],C0,0,0,0),   P0[10],P0[11],P0[12],P0[13], pw1[0]=PKW(P0,8), pw1[1]=PKW(P0,10), pw1); \
    VRD(5); SBAR(); GAPA(C1=__builtin_amdgcn_mfma_f32_32x32x16_bf16(kf[3],qr[1],C1,0,0,0),   P0[14],P0[15],P1[0],P1[1],   pw1[2]=PKW(P0,12),pw1[3]=PKW(P0,14), pw1); \
    VRD(2); SBAR(); GAPA(C0=__builtin_amdgcn_mfma_f32_32x32x16_bf16(kf[4],qr[2],C0,0,0,0),   P1[2],P1[3],P1[4],P1[5],     pw2[0]=PKW(P1,0), pw2[1]=PKW(P1,2), pw2); \
    VRD(6); SBAR(); GAPA(C1=__builtin_amdgcn_mfma_f32_32x32x16_bf16(kf[5],qr[2],C1,0,0,0),   P1[6],P1[7],P1[8],P1[9],     pw2[2]=PKW(P1,4), pw2[3]=PKW(P1,6), pw2); \
    VRD(3); SBAR(); GAPA(C0=__builtin_amdgcn_mfma_f32_32x32x16_bf16(kf[6],qr[3],C0,0,0,0),   P1[10],P1[11],P1[12],P1[13], pw3[0]=PKW(P1,8), pw3[1]=PKW(P1,10), pw3); \
    VRD(7); SBAR(); GAPA(C1=__builtin_amdgcn_mfma_f32_32x32x16_bf16(kf[7],qr[3],C1,0,0,0),   P1[14],P1[15],0.f,0.f,       pw3[2]=PKW(P1,12),pw3[3]=PKW(P1,14), pw3); \
    l_reg+=sacc; \
    if(GK){DMA_K((t)+3,sl_cur);} if(GV){DMA_V((t)+1,sl_next);} \
    CMASK(C0,C1,t); \
    { float a=MX3(C0[0],C0[1],C1[0]),b=MX3(C0[2],C0[3],C1[1]); a=MX3(a,C1[2],C1[3]); \
      _Pragma("unroll") for(int r=4;r<16;r+=4){a=MX3(a,C0[r],C0[r+1]);b=MX3(b,C0[r+2],C0[r+3]);a=MX3(a,C1[r],C1[r+1]);b=MX3(b,C1[r+2],C1[r+3]);} \
      float rm=__builtin_fmaxf(a,b); { auto rr=__builtin_amdgcn_permlane32_swap(__float_as_uint(rm),__float_as_uint(rm),false,false); rm=__builtin_fmaxf(__uint_as_float(rr[0]),__uint_as_float(rr[1])); } \
      resc=false; \
      if(__builtin_expect(__any(rm>(float)THRL),0)){ const float dl=__builtin_fmaxf(rm,0.f); mhat+=dl; \
        _Pragma("unroll") for(int r=0;r<16;++r){C0[r]-=dl;C1[r]-=dl;} MHSPLIT(); \
        const float f=__builtin_amdgcn_exp2f(-dl); l_reg*=f; if(hi==0)wsf[r32]=f; resc=true; } } \
    SBAR(); \
    float braw0_=0.f,braw1_=0.f; \
    GAPB(o[0]=__builtin_amdgcn_mfma_f32_32x32x16_bf16(PAF(0),VFR(0),o[0],0,0,0), C0,0); \
    if(GV){LOADBR((t)+1); SBAR();} \
    GAPB(o[1]=__builtin_amdgcn_mfma_f32_32x32x16_bf16(PAF(0),VFR(4),o[1],0,0,0), C0,4); \
    if(GV){MAKEBF(NB0,NB1); SBAR();} \
    KRD(GL,0); GAPB(o[0]=__builtin_amdgcn_mfma_f32_32x32x16_bf16(PAF(1),VFR(1),o[0],0,0,0), C0,8); \
    KRD(GL,1); GAPB(o[1]=__builtin_amdgcn_mfma_f32_32x32x16_bf16(PAF(1),VFR(5),o[1],0,0,0), C0,12); \
    KRD(GL,2); GAPB(o[0]=__builtin_amdgcn_mfma_f32_32x32x16_bf16(PAF(2),VFR(2),o[0],0,0,0), C1,0); \
    KRD(GL,3); GAPB(o[1]=__builtin_amdgcn_mfma_f32_32x32x16_bf16(PAF(2),VFR(6),o[1],0,0,0), C1,4); \
    GAPB(o[0]=__builtin_amdgcn_mfma_f32_32x32x16_bf16(PAF(3),VFR(3),o[0],0,0,0), C1,8); \
    GAPB(o[1]=__builtin_amdgcn_mfma_f32_32x32x16_bf16(PAF(3),VFR(7),o[1],0,0,0), C1,12); \
    }while(0)
  int t=1;
  #undef CMASK
  #define CMASK(P0,P1,t) do{}while(0)
  for(;t+5<NT;t+=2){
    STEP(pB0,pB1,pA0,pA1,t,true,true,true,abA0,abA1,abA0,abA1);     WAIT_BAR(2); RESC(); ROT();
    STEP(pA0,pA1,pB0,pB1,t+1,true,true,true,abA0,abA1,abA0,abA1);   WAIT_BAR(2); RESC(); ROT();
  }
  #undef CMASK
  #define CMASK(P0,P1,t) do{int jb_=(t)-(NT-4); if(jb_>=0)cmask(P0,P1,jb_,qrel,hi);}while(0)
  #define ENDW(tt) do{ if((tt)+3<NT){WAIT_BAR(2);} else if((tt)+2<NT){WAIT_BAR(1);} else {WAIT_BAR(0);} }while(0)
  for(;t+1<NT;t+=2){
    STEP(pB0,pB1,pA0,pA1,t,(t+3<NT),(t+1<NT),(t+1<NT),abA0,abA1,abA0,abA1);       ENDW(t);   RESC(); ROT();
    STEP(pA0,pA1,pB0,pB1,t+1,(t+4<NT),(t+2<NT),(t+2<NT),abA0,abA1,abA0,abA1);     ENDW(t+1); RESC(); ROT();
  }
  STEP(pB0,pB1,pA0,pA1,NT-1,false,false,false,abA0,abA1,abA0,abA1); RESC();
  { float sacc=pB0[0]+pB0[1]; _Pragma("unroll") for(int r=2;r<16;++r)sacc+=pB0[r]; _Pragma("unroll") for(int r=0;r<16;++r)sacc+=pB1[r]; l_reg+=sacc;
    pw0=(u32x4){PKW(pB0,0),PKW(pB0,2),PKW(pB0,4),PKW(pB0,6)};pw1=(u32x4){PKW(pB0,8),PKW(pB0,10),PKW(pB0,12),PKW(pB0,14)};pw2=(u32x4){PKW(pB1,0),PKW(pB1,2),PKW(pB1,4),PKW(pB1,6)};pw3=(u32x4){PKW(pB1,8),PKW(pB1,10),PKW(pB1,12),PKW(pB1,14)};
    SBAR(); pv(o,vb0+sl_cur,PAF(0),PAF(1),PAF(2),PAF(3)); }
  #undef PKW
  #undef PAF
  #undef VFR
  #undef PIN
  #undef MX3
  #undef GAPA
  #undef GAPB
  #undef EX
  #undef VRD
  #undef KRD
  #undef STEP
  #undef ENDW
  {auto rr=__builtin_amdgcn_permlane32_swap(__float_as_uint(l_reg),__float_as_uint(l_reg),false,false);l_reg=__uint_as_float(rr[0])+__uint_as_float(rr[1]);}
  if(hi==0)wsf[32+r32]=l_reg;asm volatile("s_waitcnt lgkmcnt(0)":::"memory");
  float rli[16];
  #pragma unroll
  for(int r=0;r<16;++r)rli[r]=__builtin_amdgcn_rcpf(wsf[32+crow(r,hi)]);
  bf16*Ow=O+(rowbase+q0+wid*QBLK)*DM+h*D;
  { bf16*stg=(bf16*)(shm+LDS_OST)+wid*2048;
    #pragma unroll
    for(int r=0;r<16;++r){const int orow=crow(r,hi);
      #pragma unroll
      for(int d0=0;d0<2;++d0)stg[orow*64+d0*32+r32]=__float2bfloat16(o[d0][r]*rli[r]);}
    asm volatile("s_waitcnt lgkmcnt(0)":::"memory");
    #pragma unroll
    for(int i=0;i<4;++i){int lane_e=lane; asm volatile("":"+v"(lane_e)); const int row=i*8+(lane_e>>3),ch=lane_e&7; const u32x4 v=*(const u32x4*)(stg+row*64+ch*8); ATTN_STORE16(Ow+(long)row*DM+ch*8,v);} }
  asm volatile("s_waitcnt lgkmcnt(0)\n\ts_barrier":::"memory");
  #undef DMA_K
  #undef DMA_V
  #undef CMASK
  #undef START
  #undef RESC
  #undef ROT
  #undef LOADBF
  #undef LOADBR
  #undef MAKEBF
  #undef BFRAG
  #undef MHSPLIT
  #undef BF8
}
constexpr int ATTN_LDS_BYTES=LDS_BYTES;
struct AttnTensors { const bf16* Q; const bf16* K; const bf16* V; bf16* O; const float* CS; const float* TOT; };
struct AttnUnit { int bh; int qb; };
struct StaticOrder {
  int vcu, grid_;
  __device__ __forceinline__ explicit StaticOrder(int grid,int block):vcu((grid%8==0)?(block%8)*(grid/8)+block/8:block),grid_(grid){}
  __device__ __forceinline__ bool next(int i,AttnUnit&u)const{ if(grid_!=256){ const int un=i*grid_+vcu; if(un>=BATCH*NHEAD*NQB)return false; u.bh=un/NQB; u.qb=NQB-1-(un%NQB); return true; }
    if(i>=8)return false; const int s=vcu&7, ii=i&3; u.bh=(vcu>>3)+32*(i>>2); u.qb=(ii==0)?31-s:(ii==1)?16+s:(ii==2)?15-s:s; return true; }
  __device__ __forceinline__ void a_ready(const AttnUnit&)const{}
  __device__ __forceinline__ void done(const AttnUnit&)const{}
};
template<class Sched,int THRL=64> __device__ __forceinline__ void attn_phase(char*lds,const AttnTensors&T,const Sched&S,const int tid){
  AttnUnit u;
  for(int i=0;S.next(i,u);++i){ S.a_ready(u); attn_unit<THRL>(u.bh/NHEAD,u.bh%NHEAD,u.qb,T.Q,T.K,T.V,T.O,T.CS,T.TOT,lds,tid); S.done(u); }
}
#undef SBAR
#undef WAIT_BAR
}
namespace cg = cooperative_groups;
#define LAS __attribute__((address_space(3)))
#define GASM __attribute__((address_space(1)))
typedef unsigned short bf16;
typedef unsigned v4u __attribute__((ext_vector_type(4)));
typedef unsigned v2u __attribute__((ext_vector_type(2)));
typedef float f32x4 __attribute__((ext_vector_type(4)));
typedef float f32x2 __attribute__((ext_vector_type(2)));
typedef float f32x16 __attribute__((ext_vector_type(16)));
typedef short bf16x8 __attribute__((ext_vector_type(8)));
using pg8::O_YP; using pg8::O_PCA; using pg8::O_PFC; using pg8::O_SCA; using pg8::O_SFC;
static_assert(attn_body::LDS_BYTES <= 131072, "attention LDS");
struct Args { const float* in[22]; float* out; unsigned char* ws; };
enum { I_XP = 0, I_XS, I_SCA, I_SFC, I_CK, I_CV, I_CLF, I_ANORM, I_WAIN, I_ACW, I_WAOUT, I_KVNORM, I_WKV, I_BF, I_BNORM, I_WQ, I_WO, I_FNORM, I_WUP, I_FCW, I_WDN, I_FINAL };

__device__ __forceinline__ unsigned f2bf(float f) { unsigned u = __builtin_bit_cast(unsigned, f); return (u + 0x7fffu + ((u >> 16) & 1u)) >> 16; }
__device__ __forceinline__ unsigned pk2(float lo, float hi) { return pg8::cvt_pk_bf16(lo, hi); }
__device__ __forceinline__ float bflo(unsigned w) { return __uint_as_float(w << 16); }
__device__ __forceinline__ float bfhi(unsigned w) { return __uint_as_float(w & 0xffff0000u); }
#define LDS_WAIT() asm volatile("s_waitcnt lgkmcnt(0)" ::: "memory")
__device__ __forceinline__ float wave_sum(float v) {
#pragma unroll
    for (int o = 1; o < 64; o <<= 1) v += __shfl_xor(v, o);
    return v;
}
__device__ __forceinline__ void transpose_item(const float* W, int K, int N, const float* gain, bf16* WT, LAS float* scr, int kb, int srcn0, int valid, int dstn0, int lane) {
    const int k0 = 64 * kb, c = lane & 31;
    float wv[32];
#pragma unroll
    for (int i = 0; i < 32; ++i) { const int kk = 2 * i + (lane >> 5); wv[i] = (c < valid) ? __builtin_nontemporal_load(W + (size_t)(k0 + kk) * N + srcn0 + c) : 0.f; }
    if (gain) {
#pragma unroll
        for (int i = 0; i < 32; ++i) wv[i] *= gain[k0 + 2 * i + (lane >> 5)];
    }
#pragma unroll
    for (int i = 0; i < 32; ++i) scr[(2 * i + (lane >> 5)) * 33 + c] = wv[i];
    LDS_WAIT(); asm volatile("" ::: "memory");
    const int c8 = lane & 7;
#pragma unroll
    for (int j = 0; j < 4; ++j) { const int n = (lane >> 3) + 8 * j; const LAS float* s = scr + (8 * c8) * 33 + n;
        v4u o; o.x = pk2(s[0 * 33], s[1 * 33]); o.y = pk2(s[2 * 33], s[3 * 33]); o.z = pk2(s[4 * 33], s[5 * 33]); o.w = pk2(s[6 * 33], s[7 * 33]);
        *(v4u*)(WT + (size_t)(dstn0 + n) * K + k0 + 8 * c8) = o; }
    LDS_WAIT(); asm volatile("" ::: "memory");
}

__device__ __forceinline__ void p0_prologue(const Args& a, LAS unsigned char* lds, int vcu, int G, int wave, int lane) {
    LAS float* scr = (LAS float*)(lds + wave * 16384);
    const int gw = vcu * NWAVES + wave, NGW = G * NWAVES;
    unsigned char* ws = a.ws;
    constexpr int I0 = 16 * 96, I1 = 16 * 32, I2 = 16 * 176, I4 = 44 * 32, I6 = 16 * 104, I7 = 16 * 32;
    constexpr int NITEMS = I0 + I1 + 2 * I2 + 2 * I4 + I6 + I7;
    for (int it = gw; it < NITEMS; it += NGW) {
        int r = it;
        if (r < I0) { const int kb = r / 96, np = 32 * (r % 96), tile = np >> 8, bj = (np & 255) >> 7, j = np & 127;
            const int src = tile < 8 ? 1024 + 1024 * bj + 128 * tile + j : np - 2048;
            transpose_item(a.in[I_WAIN], 1024, 3072, a.in[I_ANORM], (bf16*)(ws + WS_WAIN), scr, kb, src, 32, np, lane); continue; } r -= I0;
        if (r < I1) { transpose_item(a.in[I_WAOUT], 1024, 1024, nullptr, (bf16*)(ws + WS_WAOUT), scr, r / 32, 32 * (r % 32), 32, 32 * (r % 32), lane); continue; } r -= I1;
        if (r < 2 * I2) { const int l = r / I2; r -= l * I2; const int kb = r / 176, np = 32 * (r % 176), tile = np >> 8, bj = (np & 255) >> 7, j = np & 127;
            transpose_item(a.in[I_WUP] + (size_t)l * 1024 * FF2, 1024, FF2, a.in[I_FNORM] + l * 1024, (bf16*)(ws + WS_WUP) + (size_t)l * FF2 * 1024, scr, kb, bj * FF + 128 * tile + j, 32, np, lane); continue; } r -= 2 * I2;
        if (r < 2 * I4) { const int l = r / I4; r -= l * I4;
            transpose_item(a.in[I_WDN] + (size_t)l * FF * 1024, FF, 1024, nullptr, (bf16*)(ws + WS_WDN) + (size_t)l * 1024 * FF, scr, r / 32, 32 * (r % 32), 32, 32 * (r % 32), lane); continue; } r -= 2 * I4;
        if (r < I6) { const int kb = r / 104, np = 32 * (r % 104);
            if (np < 2048) transpose_item(a.in[I_WKV], 1024, 2064, a.in[I_KVNORM], (bf16*)(ws + WS_WKVQ), scr, kb, np, 32, np, lane);
            else if (np < 3072) transpose_item(a.in[I_WQ], 1024, 1024, a.in[I_BNORM], (bf16*)(ws + WS_WKVQ), scr, kb, np - 2048, 32, np, lane);
            else transpose_item(a.in[I_WKV], 1024, 2064, a.in[I_KVNORM], (bf16*)(ws + WS_WKVQ), scr, kb, 2048, np == 3072 ? 16 : 0, np, lane);
            continue; } r -= I6;
        transpose_item(a.in[I_WO], 1024, 1024, nullptr, (bf16*)(ws + WS_WO), scr, r / 32, 32 * (r % 32), 32, 32 * (r % 32), lane);
    }
    bf16* X = (bf16*)(ws + WS_X); float* ssq0 = (float*)(ws + WS_SSQ0);
    for (int m0 = gw; m0 < M; m0 += 2 * NGW) {
        const int m1 = m0 + NGW; const bool has1 = m1 < M;
        const float* xrow0 = m0 < MP ? a.in[I_XP] + (size_t)m0 * DM : a.in[I_XS] + (size_t)(m0 - MP) * DM;
        const float* xrow1 = !has1 ? xrow0 : (m1 < MP ? a.in[I_XP] + (size_t)m1 * DM : a.in[I_XS] + (size_t)(m1 - MP) * DM);
        const f32x4* xr0 = (const f32x4*)xrow0 + lane; const f32x4* xr1 = (const f32x4*)xrow1 + lane;
        f32x4 v0[4], v1[4]; float s0 = 0.f, s1 = 0.f;
#pragma unroll
        for (int j = 0; j < 4; ++j) { v0[j] = __builtin_nontemporal_load(xr0 + 64 * j); v1[j] = __builtin_nontemporal_load(xr1 + 64 * j); }
#pragma unroll
        for (int j = 0; j < 4; ++j) { s0 += (v0[j].x * v0[j].x + v0[j].y * v0[j].y) + (v0[j].z * v0[j].z + v0[j].w * v0[j].w); s1 += (v1[j].x * v1[j].x + v1[j].y * v1[j].y) + (v1[j].z * v1[j].z + v1[j].w * v1[j].w); }
        s0 = wave_sum(s0); s1 = wave_sum(s1);
        v2u* o80 = (v2u*)(X + (size_t)m0 * DM) + lane;
#pragma unroll
        for (int j = 0; j < 4; ++j) { v2u w; w.x = pk2(v0[j].x, v0[j].y); w.y = pk2(v0[j].z, v0[j].w); o80[64 * j] = w; }
        if (lane < SSQ_SLOTS) ssq0[(size_t)m0 * SSQ_SLOTS + lane] = lane == 0 ? s0 : 0.f;
        if (has1) {
            v2u* o81 = (v2u*)(X + (size_t)m1 * DM) + lane;
#pragma unroll
            for (int j = 0; j < 4; ++j) { v2u w; w.x = pk2(v1[j].x, v1[j].y); w.y = pk2(v1[j].z, v1[j].w); o81[64 * j] = w; }
            if (lane < SSQ_SLOTS) ssq0[(size_t)m1 * SSQ_SLOTS + lane] = lane == 0 ? s1 : 0.f;
        }
    }
}

__device__ __forceinline__ void p2_mixer(const Args& a, int vcu, int G, int tid) {
    const bf16* CU = (const bf16*)(a.ws + WS_CU); const bf16* GB = (const bf16*)(a.ws + WS_GB); bf16* MB = (bf16*)(a.ws + WS_MB);
    const float* cw = a.in[I_ACW];
    const long nth = (long)G * 512;
    for (long idx = (long)vcu * 512 + tid; idx < (long)(M / 4) * 128; idx += nth) {
        const int r0 = M - 4 - 4 * (int)(idx >> 7), c8 = (int)(idx & 127) * 8;
        int t0, b, T; const bool smp = r0 >= MP;
        if (!smp) { t0 = r0 & (TP - 1); b = r0 >> 13; T = TP; } else { t0 = (r0 - MP) & 31; b = (r0 - MP) >> 5; T = 32; }
        v4u xr[6], gr[4];
#pragma unroll
        for (int i = 0; i < 4; ++i) { xr[2 + i] = *(const v4u*)(CU + (size_t)(r0 + i) * DM + c8); gr[i] = __builtin_nontemporal_load((const v4u*)(GB + (size_t)(r0 + i) * DM + c8)); }
        float w[6][8];
        if (t0 != 0) { xr[0] = *(const v4u*)(CU + (size_t)(r0 - 2) * DM + c8); xr[1] = *(const v4u*)(CU + (size_t)(r0 - 1) * DM + c8); }
        else { xr[0] = (v4u){0u, 0u, 0u, 0u}; xr[1] = xr[0]; }
#pragma unroll
        for (int i = 0; i < 6; ++i) { w[i][0] = bflo(xr[i].x); w[i][1] = bfhi(xr[i].x); w[i][2] = bflo(xr[i].y); w[i][3] = bfhi(xr[i].y); w[i][4] = bflo(xr[i].z); w[i][5] = bfhi(xr[i].z); w[i][6] = bflo(xr[i].w); w[i][7] = bfhi(xr[i].w); }
        if (t0 == 0 && smp) { const float* st = a.in[I_SCA] + (size_t)b * 2 * DM + c8;
#pragma unroll
            for (int e = 0; e < 8; ++e) { w[0][e] = st[e]; w[1][e] = st[DM + e]; } }
        float c0[8], c1[8], c2[8];
#pragma unroll
        for (int e = 0; e < 8; ++e) { c0[e] = cw[c8 + e]; c1[e] = cw[DM + c8 + e]; c2[e] = cw[2 * DM + c8 + e]; }
#pragma unroll
        for (int i = 0; i < 4; ++i) {
            const v4u gx = gr[i];
            float g[8]; g[0] = bflo(gx.x); g[1] = bfhi(gx.x); g[2] = bflo(gx.y); g[3] = bfhi(gx.y); g[4] = bflo(gx.z); g[5] = bfhi(gx.z); g[6] = bflo(gx.w); g[7] = bfhi(gx.w);
            float o[8];
#pragma unroll
            for (int e = 0; e < 8; ++e) o[e] = g[e] * (c0[e] * w[i][e] + c1[e] * w[i + 1][e] + c2[e] * w[i + 2][e]);
            v4u ww; ww.x = pk2(o[0], o[1]); ww.y = pk2(o[2], o[3]); ww.z = pk2(o[4], o[5]); ww.w = pk2(o[6], o[7]);
            *(v4u*)(MB + (size_t)(r0 + i) * DM + c8) = ww;
        }
        if (t0 == T - 4) {
#pragma unroll
            for (int j = 0; j < 2; ++j) { float* d = a.out + (smp ? O_SCA : O_PCA) + ((size_t)b * 2 + j) * DM + c8;
#pragma unroll
                for (int e = 0; e < 8; ++e) d[e] = w[4 + j][e]; }
        }
    }
}

__device__ __forceinline__ float silu_f(float x) { return x * __builtin_amdgcn_rcpf(1.0f + __builtin_amdgcn_exp2f(-x * LOG2E)); }
__device__ __forceinline__ void p5_ffn_elem(const Args& a, int l, int vcu, int G, int wave, int lane, const bool nostore) {
    bf16* UP = (bf16*)(a.ws + WS_UP); const bf16* HALO = (const bf16*)(a.ws + WS_HALO);
    const int gw = vcu * NWAVES + wave, NGW = G * NWAVES;
    const float* cw = a.in[I_FCW] + (size_t)l * 3 * FF2;
    const float* ssq = (const float*)(a.ws + WS_SSQ0 + (size_t)(l ? 3 : 1) * SSQ_BYTES);
    for (int it = gw; it < 264 * 22; it += NGW) {
        const int blk = 263 - it / 22, pn = it % 22, row0 = blk * 128;
        const int colm = 256 * pn + 2 * lane, cg_ = 128 * pn + 2 * lane, cv_ = FF + cg_;
        const bool smp = row0 >= MP;
        f32x2 wg[3], wv[3];
#pragma unroll
        for (int i = 0; i < 3; ++i) { wg[i] = *(const f32x2*)(cw + i * FF2 + cg_); wv[i] = *(const f32x2*)(cw + i * FF2 + cv_); }
        f32x2 g1 = {0.f, 0.f}, g2 = {0.f, 0.f}, v1 = {0.f, 0.f}, v2 = {0.f, 0.f};
        const bool has_halo = !smp && (row0 & (TP - 1)) != 0;
        float rsA, rsB, rsH = 0.f;
        { const float* sa = ssq + (size_t)(row0 + lane) * SSQ_SLOTS; const float* sb = sa + (size_t)64 * SSQ_SLOTS; const float* sh = ssq + (size_t)(row0 - 2 + (lane & 1)) * SSQ_SLOTS;
          float ta = 0.f, tb = 0.f, th = 0.f;
#pragma unroll
          for (int j = 0; j < SSQ_SLOTS / 4; ++j) { const f32x4 x = *(const f32x4*)(sa + 4 * j), y = *(const f32x4*)(sb + 4 * j); ta += (x.x + x.y) + (x.z + x.w); tb += (y.x + y.y) + (y.z + y.w); }
          if (has_halo) {
#pragma unroll
              for (int j = 0; j < SSQ_SLOTS / 4; ++j) { const f32x4 z = *(const f32x4*)(sh + 4 * j); th += (z.x + z.y) + (z.z + z.w); }
              rsH = __builtin_amdgcn_rsqf(th * (1.0f / 1024.0f) + pg8::RMS_EPS);
          }
          rsA = __builtin_amdgcn_rsqf(ta * (1.0f / 1024.0f) + pg8::RMS_EPS); rsB = __builtin_amdgcn_rsqf(tb * (1.0f / 1024.0f) + pg8::RMS_EPS); }
        if (has_halo) {
            const unsigned hg2 = *(const unsigned*)(HALO + (size_t)((blk - 1) * 2 + 0) * FF2 + colm), hv2 = *(const unsigned*)(HALO + (size_t)((blk - 1) * 2 + 0) * FF2 + colm + 128);
            const unsigned hg1 = *(const unsigned*)(HALO + (size_t)((blk - 1) * 2 + 1) * FF2 + colm), hv1 = *(const unsigned*)(HALO + (size_t)((blk - 1) * 2 + 1) * FF2 + colm + 128);
            const float r2 = __shfl(rsH, 0), r1 = __shfl(rsH, 1);
            g2 = (f32x2){bflo(hg2), bfhi(hg2)} * r2; v2 = (f32x2){bflo(hv2), bfhi(hv2)} * r2; g1 = (f32x2){bflo(hg1), bfhi(hg1)} * r1; v1 = (f32x2){bflo(hv1), bfhi(hv1)} * r1;
        }
        for (int rb = 0; rb < 128; rb += 16) {
            unsigned gr[16], vr[16], orr[16];
#pragma unroll
            for (int i = 0; i < 16; ++i) { const bf16* p = UP + (size_t)(row0 + rb + i) * FF2 + colm; gr[i] = __builtin_nontemporal_load((const unsigned*)p); vr[i] = __builtin_nontemporal_load((const unsigned*)(p + 128)); }
            if (smp && (rb & 31) == 0) {
                const int b = (row0 + rb - MP) >> 5; const float* st = a.in[I_SFC] + ((size_t)(l * 32 + b) * 2) * FF2;
                g2 = *(const f32x2*)(st + cg_); v2 = *(const f32x2*)(st + cv_); g1 = *(const f32x2*)(st + FF2 + cg_); v1 = *(const f32x2*)(st + FF2 + cv_);
            }
            const float rsSel = rb < 64 ? rsA : rsB;
#pragma unroll
            for (int i = 0; i < 16; ++i) {
                const float rsr = __shfl(rsSel, (rb & 63) + i);
                const f32x2 g0 = (f32x2){bflo(gr[i]), bfhi(gr[i])} * rsr, v0 = (f32x2){bflo(vr[i]), bfhi(vr[i])} * rsr;
                const f32x2 cg = wg[0] * g2 + wg[1] * g1 + wg[2] * g0, cv = wv[0] * v2 + wv[1] * v1 + wv[2] * v0;
                orr[i] = pk2(silu_f(cg.x) * cv.x, silu_f(cg.y) * cv.y);
                g2 = g1; g1 = g0; v2 = v1; v1 = v0;
                const int rr = rb + i;
                const bool last2 = smp ? ((rr & 31) >= 30) : (((blk & 63) == 63) && rr >= 126);
                if (last2) {
                    const int row = row0 + rr; const int j = smp ? (rr & 31) - 30 : rr - 126;
                    float* d = smp ? a.out + O_SFC + ((size_t)(l * 32 + ((row - MP) >> 5)) * 2 + j) * FF2 : a.out + O_PFC + ((size_t)(l * 4 + (row >> 13)) * 2 + j) * FF2;
                    *(f32x2*)(d + cg_) = g0; *(f32x2*)(d + cv_) = v0;
                }
            }
#pragma unroll
            for (int i = 0; i < 16; ++i) { if (!nostore) *(unsigned*)(UP + (size_t)(row0 + rb + i) * FF2 + colm) = orr[i]; else asm volatile("" :: "v"(orr[i])); }
        }
    }
}

__device__ __forceinline__ void p8_scan(const Args& a, int bh, LAS unsigned char* lds, int wave, int lane) {
    const float* LOGF = (const float*)(a.ws + WS_LOGF); float* BT = (float*)(a.ws + WS_CS);
    LAS float* tot = (LAS float*)lds;
    const int b = bh >> 4, h = bh & 15;
    float v[4][4];
#pragma unroll
    for (int c = 0; c < 4; ++c) {
        const size_t base = (size_t)b * TP + 256 * (4 * wave + c);
#pragma unroll
        for (int j = 0; j < 4; ++j) v[c][j] = LOGF[(base + 64 * j + lane) * 16 + h];
    }
#pragma unroll
    for (int c = 0; c < 4; ++c) {
        float off = 0.f;
#pragma unroll
        for (int j = 0; j < 4; ++j) {
            float s = v[c][j];
#pragma unroll
            for (int d = 1; d < 64; d <<= 1) { const float t = __shfl_up(s, d); if (lane >= d) s += t; }
            v[c][j] = s + off;
            off += __shfl(s, 63);
        }
        if (lane == 0) tot[4 * wave + c] = off;
    }
    __syncthreads();
    float pre = 0.f;
    for (int i = 0; i < 4 * wave; ++i) pre += tot[i];
#pragma unroll
    for (int c = 0; c < 4; ++c) {
#pragma unroll
        for (int j = 0; j < 4; ++j) BT[(size_t)bh * TP + 256 * (4 * wave + c) + 64 * j + lane] = -(v[c][j] + pre) * LOG2E;
        pre += tot[4 * wave + c];
    }
    __syncthreads();
}

__device__ __forceinline__ void sample_unit(const Args& a, int b, int h, LAS unsigned char* lds, int tid, int lane, int wid) {
    bf16* QB = (bf16*)(a.ws + WS_QB); const bf16* KB = (const bf16*)(a.ws + WS_KB); const bf16* VB = (const bf16*)(a.ws + WS_VB); const float* LOGF = (const float*)(a.ws + WS_LOGF);
    LAS float* cs = (LAS float*)lds;
    LAS float* mw = (LAS float*)(lds + 8192);
    LAS float* lw = mw + 256;
    LAS float* Ow = (LAS float*)(lds + 16384);
    const int r32 = lane & 31, hi = lane >> 5;
    const float* clf = a.in[I_CLF] + (size_t)b * 1024 * 16 + h;
    {
      const float c0_ = __builtin_nontemporal_load(clf + (size_t)tid * 16), c1_ = __builtin_nontemporal_load(clf + (size_t)(tid + 512) * 16);
      float c2_ = 0.f; if (tid < 32) c2_ = LOGF[(size_t)(MP + b * 32 + tid) * 16 + h];
      cs[tid] = c0_; cs[tid + 512] = c1_; if (tid < 64) cs[1024 + tid] = c2_; }
    __syncthreads();
    if (wid == 0) {
        float v[17]; float s = 0.f;
#pragma unroll
        for (int i = 0; i < 17; ++i) { s += cs[17 * lane + i]; v[i] = s; }
        float inc = s;
#pragma unroll
        for (int d = 1; d < 64; d <<= 1) { const float t = __shfl_up(inc, d); if (lane >= d) inc += t; }
        const float ex = inc - s;
#pragma unroll
        for (int i = 0; i < 17; ++i) cs[17 * lane + i] = v[i] + ex;
    }
    __syncthreads();
    const float cref = cs[1023];
    const size_t qrow = (size_t)(MP + b * 32 + r32) * DM + h * 64;
    bf16x8 qr[4];
#pragma unroll
    for (int d0 = 0; d0 < 4; ++d0) qr[d0] = *(const GASM bf16x8*)(QB + qrow + d0 * 16 + hi * 8);
    float m = -INFINITY, l = 0.f;
    f32x16 o[2]; o[0] = f32x16{}; o[1] = f32x16{};
    const int ntl = 4 + (wid == 0 ? 1 : 0);
#pragma unroll 1
    for (int s = 0; s < ntl; ++s) {
        const int j = s < 4 ? wid + 8 * s : 32;
        f32x16 p;
#pragma unroll
        for (int r = 0; r < 16; ++r) p[r] = (cref - cs[32 * j + attn_body::crow(r, hi)]) * LOG2E;
        float vv[2][2][8];
        if (s < 4) {
            const GASM float* kp = (const GASM float*)a.in[I_CK] + (((size_t)b * 1024 + 32 * j + r32) * 16 + h) * 64 + hi * 8;
            f32x4 kx[4], ky[4];
#pragma unroll
            for (int d0 = 0; d0 < 4; ++d0) { kx[d0] = __builtin_nontemporal_load((const GASM f32x4*)(kp + d0 * 16)); ky[d0] = __builtin_nontemporal_load((const GASM f32x4*)(kp + d0 * 16 + 4)); }
#pragma unroll
            for (int ks = 0; ks < 2; ++ks)
#pragma unroll
                for (int d0 = 0; d0 < 2; ++d0) { const GASM float* vp = (const GASM float*)a.in[I_CV] + (((size_t)b * 1024 + 32 * j + 16 * ks + 4 * hi) * 16 + h) * 64 + 32 * d0 + r32;
#pragma unroll
                    for (int i = 0; i < 8; ++i) vv[ks][d0][i] = __builtin_nontemporal_load(vp + (size_t)((i & 3) + 8 * (i >> 2)) * 1024); }
#pragma unroll
            for (int d0 = 0; d0 < 4; ++d0) {
                const f32x4 x = kx[d0], y = ky[d0];
                v4u w; w.x = pk2(x.x, x.y); w.y = pk2(x.z, x.w); w.z = pk2(y.x, y.y); w.w = pk2(y.z, y.w);
                p = __builtin_amdgcn_mfma_f32_32x32x16_bf16(__builtin_bit_cast(bf16x8, w), qr[d0], p, 0, 0, 0);
            }
        } else {
#pragma unroll
            for (int ks = 0; ks < 2; ++ks)
#pragma unroll
                for (int d0 = 0; d0 < 2; ++d0) { const GASM bf16* vp = (const GASM bf16*)VB + (size_t)(MP + b * 32 + 16 * ks + 4 * hi) * DM + h * 64 + 32 * d0 + r32;
#pragma unroll
                    for (int i = 0; i < 8; ++i) vv[ks][d0][i] = bflo((unsigned)vp[(size_t)((i & 3) + 8 * (i >> 2)) * DM]); }
#pragma unroll
            for (int d0 = 0; d0 < 4; ++d0) p = __builtin_amdgcn_mfma_f32_32x32x16_bf16(*(const GASM bf16x8*)(KB + qrow + d0 * 16 + hi * 8), qr[d0], p, 0, 0, 0);
#pragma unroll
            for (int r = 0; r < 16; ++r) if (attn_body::crow(r, hi) > r32) p[r] = -INFINITY;
        }
        float mt = p[0];
#pragma unroll
        for (int r = 1; r < 16; ++r) mt = fmaxf(mt, p[r]);
        mt = fmaxf(mt, __shfl_xor(mt, 32));
        const float mn = fmaxf(m, mt), alpha = __builtin_amdgcn_exp2f(m - mn);
        float lt = 0.f;
#pragma unroll
        for (int r = 0; r < 16; ++r) { p[r] = __builtin_amdgcn_exp2f(p[r] - mn); lt += p[r]; }
        lt += __shfl_xor(lt, 32);
        l = l * alpha + lt; m = mn;
#pragma unroll
        for (int r = 0; r < 16; ++r) { const float ar = __shfl(alpha, attn_body::crow(r, hi)); o[0][r] *= ar; o[1][r] *= ar; }
#pragma unroll
        for (int ks = 0; ks < 2; ++ks) {
            v4u pw; pw.x = pk2(p[8 * ks], p[8 * ks + 1]); pw.y = pk2(p[8 * ks + 2], p[8 * ks + 3]); pw.z = pk2(p[8 * ks + 4], p[8 * ks + 5]); pw.w = pk2(p[8 * ks + 6], p[8 * ks + 7]);
            const bf16x8 pa = __builtin_bit_cast(bf16x8, pw);
#pragma unroll
            for (int d0 = 0; d0 < 2; ++d0) {
                v4u vw; vw.x = pk2(vv[ks][d0][0], vv[ks][d0][1]); vw.y = pk2(vv[ks][d0][2], vv[ks][d0][3]); vw.z = pk2(vv[ks][d0][4], vv[ks][d0][5]); vw.w = pk2(vv[ks][d0][6], vv[ks][d0][7]);
                o[d0] = __builtin_amdgcn_mfma_f32_32x32x16_bf16(pa, __builtin_bit_cast(bf16x8, vw), o[d0], 0, 0, 0);
            }
        }
    }
    if (hi == 0) { mw[wid * 32 + r32] = m; lw[wid * 32 + r32] = l; }
#pragma unroll
    for (int r = 0; r < 16; ++r)
#pragma unroll
        for (int d0 = 0; d0 < 2; ++d0) Ow[(wid * 32 + attn_body::crow(r, hi)) * 64 + 32 * d0 + r32] = o[d0][r];
    __syncthreads();
    {
        const int q = tid >> 4, dg = (tid & 15) * 4;
        float Mx = mw[q];
#pragma unroll
        for (int w = 1; w < 8; ++w) Mx = fmaxf(Mx, mw[w * 32 + q]);
        float Ls = 0.f; f32x4 acc = {0.f, 0.f, 0.f, 0.f};
#pragma unroll
        for (int w = 0; w < 8; ++w) { const float sc = __builtin_amdgcn_exp2f(mw[w * 32 + q] - Mx); Ls += lw[w * 32 + q] * sc; acc += *(const LAS f32x4*)(Ow + (w * 32 + q) * 64 + dg) * sc; }
        const float inv = 1.0f / Ls;
        v2u w2; w2.x = pk2(acc.x * inv, acc.y * inv); w2.y = pk2(acc.z * inv, acc.w * inv);
        *(GASM v2u*)(QB + (size_t)(MP + b * 32 + q) * DM + h * 64 + dg) = w2;
    }
    __syncthreads();
}

__device__ __forceinline__ void p14_final(const Args& a, int vcu, int G, int wave, int lane) {
    const bf16* X = (const bf16*)(a.ws + WS_X); const float* ssq = (const float*)(a.ws + WS_SSQ4);
    const int gw = vcu * NWAVES + wave, NGW = G * NWAVES;
    f32x4 gn[4];
#pragma unroll
    for (int j = 0; j < 4; ++j) gn[j] = *((const f32x4*)a.in[I_FINAL] + 64 * j + lane);
    for (int m0 = gw; m0 < M; m0 += 2 * NGW) {
        const int m1 = (m0 + NGW < M) ? m0 + NGW : m0; const bool has1 = m0 + NGW < M;
        float s0 = 0.f, s1 = 0.f;
#pragma unroll
        for (int j = 0; j < SSQ_SLOTS / 4; ++j) { const f32x4 p = *(const f32x4*)(ssq + (size_t)m0 * SSQ_SLOTS + 4 * j), q = *(const f32x4*)(ssq + (size_t)m1 * SSQ_SLOTS + 4 * j); s0 += (p.x + p.y) + (p.z + p.w); s1 += (q.x + q.y) + (q.z + q.w); }
        const v2u* xr0 = (const v2u*)(X + (size_t)m0 * DM) + lane; const v2u* xr1 = (const v2u*)(X + (size_t)m1 * DM) + lane;
        v2u w0[4], w1[4];
#pragma unroll
        for (int j = 0; j < 4; ++j) { w0[j] = xr0[64 * j]; w1[j] = xr1[64 * j]; }
        const float rs0 = __builtin_amdgcn_rsqf(s0 * (1.0f / 1024.0f) + pg8::RMS_EPS), rs1 = __builtin_amdgcn_rsqf(s1 * (1.0f / 1024.0f) + pg8::RMS_EPS);
        f32x4* o0 = (f32x4*)(a.out + O_YP + (size_t)m0 * DM) + lane; f32x4* o1 = (f32x4*)(a.out + O_YP + (size_t)m1 * DM) + lane;
#pragma unroll
        for (int j = 0; j < 4; ++j) { const f32x4 v = {bflo(w0[j].x), bfhi(w0[j].x), bflo(w0[j].y), bfhi(w0[j].y)}; __builtin_nontemporal_store(v * rs0 * gn[j], o0 + 64 * j); }
        if (has1) {
#pragma unroll
            for (int j = 0; j < 4; ++j) { const f32x4 v = {bflo(w1[j].x), bfhi(w1[j].x), bflo(w1[j].y), bfhi(w1[j].y)}; __builtin_nontemporal_store(v * rs1 * gn[j], o1 + 64 * j); }
        }
    }
}

#define RLX_AGENT __ATOMIC_RELAXED, __HIP_MEMORY_SCOPE_AGENT
#define XB_TMO      128
#define XB_XCNT(j)  (256  + 64 * (j))
#define XB_XSUB(j)  (1280 + 64 * (j))
#define XB_XGEN(j)  (2304 + 64 * (j))
#define XB_TOP      3328
#define XB_TOPGEN   3392
#define XCD_BAR_WORDS 3456
#define XB_SPIN_CAP (1u << 18)

__device__ __forceinline__ unsigned xb_ld(unsigned* p)              { return __hip_atomic_load(p, __ATOMIC_RELAXED, __HIP_MEMORY_SCOPE_AGENT); }
__device__ __forceinline__ unsigned xb_add(unsigned* p, unsigned v) { return __hip_atomic_fetch_add(p, v, __ATOMIC_RELAXED, __HIP_MEMORY_SCOPE_AGENT); }
__device__ __forceinline__ unsigned xb_xcc_id() { return (unsigned)__builtin_amdgcn_s_getreg((3 << 11) | 20) & 0xFu; }
#define XB_SPIN(cond, bar) do { unsigned _sp = 0; while (cond) { __builtin_amdgcn_s_sleep(1); \
    if ((++_sp & 255u) == 0u) { if (xb_ld(&(bar)[XB_TMO])) break; if (_sp > XB_SPIN_CAP) { atomicAdd(&(bar)[XB_TMO], 1u); break; } } } } while (0)

struct XcdBarrier {
    unsigned* bar; unsigned x;
    volatile LAS unsigned* st;
};

__device__ __forceinline__ XcdBarrier xcd_barrier_post(unsigned* bar, volatile LAS unsigned* st, bool leader) {
    XcdBarrier b; b.bar = bar; b.x = xb_xcc_id(); b.st = st;
    if (leader) (void)xb_add(&bar[XB_XCNT(b.x)], 1u);
    return b;
}
__device__ __forceinline__ void xcd_barrier_complete(unsigned* bar, unsigned x, unsigned& nloc, unsigned& nx) {
    const unsigned G = gridDim.x * gridDim.y * gridDim.z;
    unsigned sum, cnt, mine, sp = 0u;
    for (;;) {
        sum = 0u; cnt = 0u; mine = 0u;
#pragma unroll
        for (unsigned j = 0; j < 16; ++j) { const unsigned c = xb_ld(&bar[XB_XCNT(j)]); sum += c; cnt += (c > 0u) ? 1u : 0u; mine = (j == x) ? c : mine; }
        if (sum == G) break;
        __builtin_amdgcn_s_sleep(1);
        if ((++sp & 255u) == 0u) { if (xb_ld(&bar[XB_TMO])) break; if (sp > XB_SPIN_CAP) { atomicAdd(&bar[XB_TMO], 1u); break; } }
    }
    nloc = mine > 0u ? mine : 1u; nx = cnt > 0u ? cnt : 1u;
}

__device__ __forceinline__ void xcd_barrier(const XcdBarrier& b, bool leader) {
    asm volatile("s_waitcnt vmcnt(0)" ::: "memory");
    __syncthreads();
    if (leader) {
        unsigned* bar = b.bar;
        __builtin_amdgcn_s_waitcnt(0);
        unsigned nloc = b.st[0], nx = b.st[1];
        if (nloc == 0u) { xcd_barrier_complete(bar, b.x, nloc, nx); b.st[0] = nloc; b.st[1] = nx; }
        const unsigned old = xb_add(&bar[XB_XSUB(b.x)], 1u);
        const unsigned gen = old / nloc;
        if (old + 1u == (gen + 1u) * nloc) {
            __builtin_amdgcn_fence(__ATOMIC_RELEASE, "agent");
            asm volatile("s_waitcnt vmcnt(0)" ::: "memory");
            const unsigned og = xb_add(&bar[XB_TOP], 1u);
            const unsigned tg = og / nx;
            if (og + 1u == (tg + 1u) * nx) xb_add(&bar[XB_TOPGEN], 1u);
            else XB_SPIN(xb_ld(&bar[XB_TOPGEN]) == tg, bar);
            __builtin_amdgcn_fence(__ATOMIC_ACQUIRE, "agent");
            xb_add(&bar[XB_XGEN(b.x)], 1u);
            asm volatile("s_waitcnt vmcnt(0)" ::: "memory");
        } else {
            XB_SPIN(xb_ld(&bar[XB_XGEN(b.x)]) == gen, bar);
            __builtin_amdgcn_fence(__ATOMIC_ACQUIRE, "agent");
            asm volatile("s_waitcnt vmcnt(0)" ::: "memory");
        }
    }
    __syncthreads();
}


__global__ void __launch_bounds__(NWAVES * 64, 2) fwd_kernel(Args a_) {
    extern __shared__ __attribute__((aligned(16))) unsigned char lds_raw[];
    cg::grid_group grid = cg::this_grid();
    LAS unsigned char* lds = (LAS unsigned char*)lds_raw;
    const int wave0 = __builtin_amdgcn_readfirstlane(threadIdx.x >> 6);
    volatile LAS unsigned* topw = (volatile LAS unsigned*)(lds + LDS_BYTES - 64);
    if (threadIdx.x < 4) topw[threadIdx.x] = 0u;
    if (threadIdx.x == 0) { unsigned* ctl = (unsigned*)(a_.ws + WS_CTL); const unsigned xcc = xb_xcc_id(); unsigned rank = 99u;
                            if (xcc < 8u) rank = __hip_atomic_fetch_add(ctl + 3584 + 64 * xcc, 1u, __ATOMIC_RELAXED, __HIP_MEMORY_SCOPE_AGENT);
                            if (rank >= 32u || gridDim.x != 256u) __hip_atomic_store(ctl + 3584 + 64 * 8, 1u, __ATOMIC_RELAXED, __HIP_MEMORY_SCOPE_AGENT);
                            topw[4] = rank * 8u + xcc; }
    __syncthreads();
    grid.sync();
    if (threadIdx.x == 0) { if (__hip_atomic_load((unsigned*)(a_.ws + WS_CTL) + 3584 + 64 * 8, __ATOMIC_RELAXED, __HIP_MEMORY_SCOPE_AGENT) != 0u) topw[4] = blockIdx.x; }
    (void)xcd_barrier_post((unsigned*)(a_.ws + WS_CTL), topw, threadIdx.x == 0);
    __syncthreads();
#ifndef PROBE_MASK
#define PROBE_MASK 0
#endif
#ifndef PROBE_REPS
#define PROBE_REPS 1
#endif
    int ph = 0, nrep = 0;
#pragma unroll 1
    while (ph < 15) {
        const bool probe_pass = ((PROBE_MASK >> ph) & 1) && nrep < PROBE_REPS;
        int G = gridDim.x; asm volatile("" : "+s"(G));
        int bx = (int)((volatile LAS unsigned*)(lds + LDS_BYTES - 64))[4]; bx = __builtin_amdgcn_readfirstlane(bx); asm volatile("" : "+s"(bx));
        const int vcu = (G % 8 == 0) ? (bx % 8) * (G / 8) + bx / 8 : bx;
        int wv = wave0; asm volatile("" : "+s"(wv));
        unsigned z0 = 0u; asm volatile("" : "+s"(z0));
        int tid = wv * 64 + (int)__builtin_amdgcn_mbcnt_hi(~0u, __builtin_amdgcn_mbcnt_lo(~0u, z0)); asm volatile("" : "+v"(tid));
        typedef const __attribute__((address_space(4))) Args* kargs_t;
        kargs_t ap = (kargs_t)__builtin_amdgcn_kernarg_segment_ptr(); asm volatile("" : "+s"(ap));
        const Args& a = *(const Args*)ap;
        unsigned char* ws = a.ws; asm volatile("" : "+s"(ws));
        const int lane = tid & 63, wave = __builtin_amdgcn_readfirstlane(tid >> 6);
        bf16* X = (bf16*)(ws + WS_X);
        const bool is_gemm = (ph == 1 || ph == 3 || ph == 4 || ph == 6 || ph == 7 || ph == 10 || ph == 11 || ph == 13);
        if (is_gemm) {
            pg8::Gemm g; pg8::EpiAny E; E.ws = ws; E.out = a.out; E.b_f = a.in[I_BF]; E.sel = 0;
            g.M = MP; g.lda = 1024; g.apair = 256; g.K = 1024; g.A = X;
            if (ph == 1)       { g.Bt = (const bf16*)(ws + WS_WAIN); g.N = 3072; E.mode = pg8::EPI_MIX; }
            else if (ph == 3)  { g.A = (const bf16*)(ws + WS_MB); g.Bt = (const bf16*)(ws + WS_WAOUT); g.N = 1024; E.mode = pg8::EPI_RESID; E.sel = 1; }
            else if (ph == 4 || ph == 11) { const int l = ph == 11; g.Bt = (const bf16*)(ws + WS_WUP) + (size_t)l * FF2 * 1024; g.N = FF2; E.mode = pg8::EPI_UP; E.sel = l ? 3 : 1; }
            else if (ph == 6 || ph == 13) { const int l = ph == 13; g.A = (const bf16*)(ws + WS_UP); g.Bt = (const bf16*)(ws + WS_WDN) + (size_t)l * 1024 * FF; g.N = 1024; g.K = FF; g.lda = FF2; g.apair = 512;
                                 E.mode = pg8::EPI_RESID; E.sel = l ? 4 : 2; }
            else if (ph == 7)  { g.Bt = (const bf16*)(ws + WS_WKVQ); g.N = 3328; E.mode = pg8::EPI_KVQ; E.sel = 2; }
            else               { g.A = (const bf16*)(ws + WS_QB); g.Bt = (const bf16*)(ws + WS_WO); g.N = 1024; E.mode = pg8::EPI_RESID; E.sel = 3; }
#ifdef PROBE_DENSE_A
            if (probe_pass && (ph == 6 || ph == 13)) { g.lda = FF; g.apair = 256; }
#endif
            const bool upg = (ph == 4 || ph == 11 || ph == 7);
            pg8::StaticOrder S; S.init(upg ? M : MP, g.N, G, bx);
#ifdef PROBE_MODE
            if (probe_pass) E.mode = PROBE_MODE;
#elif !defined(PROBE_FULL)
            if (probe_pass) E.mode = pg8::EPI_NOP;
#endif
#ifndef SKIP_GEMM
            pg8::gemm_phase<pg8::EpiAny, pg8::StaticOrder, PG8_ALIGN, PG8_SP2>(lds, g, S, E, tid);
            if (!upg) {
              int wv2 = wave0; asm volatile("" : "+s"(wv2));
              unsigned z2 = 0u; asm volatile("" : "+s"(z2));
              int tid2 = wv2 * 64 + (int)__builtin_amdgcn_mbcnt_hi(~0u, __builtin_amdgcn_mbcnt_lo(~0u, z2)); asm volatile("" : "+v"(tid2));
              int G2 = gridDim.x; asm volatile("" : "+s"(G2)); int bx2 = (int)((volatile LAS unsigned*)(lds + LDS_BYTES - 64))[4]; bx2 = __builtin_amdgcn_readfirstlane(bx2); asm volatile("" : "+s"(bx2));
              const int vcu2 = (G2 % 8 == 0) ? (bx2 % 8) * (G2 / 8) + bx2 / 8 : bx2;
              if (ph == 3 || ph == 6 || ph == 10 || ph == 13) pg8::gemm_small64_resid(lds, g, MP, vcu2, G2, E.ws, E.sel, tid2, probe_pass);
              else pg8::gemm_small<pg8::EpiAny>(lds, g, MP, MS / 64, vcu2, G2, E, tid2);
            }
#endif
        } else if (ph == 0) {
#ifndef SKIP_P0
            p0_prologue(a, lds, vcu, G, wave, lane);
#endif
        } else if (ph == 2) {
#ifndef SKIP_P2
            p2_mixer(a, vcu, G, tid);
#endif
        } else if (ph == 5 || ph == 12) {
#ifndef SKIP_P5
            p5_ffn_elem(a, ph == 12, vcu, G, wave, lane, probe_pass);
#endif
        } else if (ph == 8) {
#ifndef SKIP_P8
            for (int bh = bx; bh < 64; bh += G) p8_scan(a, bh, lds, wave, lane);
            if (!probe_pass) for (int un = vcu; un < 512; un += G) sample_unit(a, un >> 4, un & 15, lds, tid, lane, wave);
#endif
        } else if (ph == 9) {
            const attn_body::AttnTensors AT{(const attn_body::bf16*)(ws + WS_QB), (const attn_body::bf16*)(ws + WS_KB), (const attn_body::bf16*)(ws + WS_VB), (attn_body::bf16*)(ws + (probe_pass ? WS_BIG + 3 * X_BYTES : WS_QB)), (const float*)(ws + WS_CS), (const float*)(ws + WS_TOT)};
            const attn_body::StaticOrder S((int)G, (int)bx);
#ifndef SKIP_ATTN
            attn_body::attn_phase<attn_body::StaticOrder>((char*)lds_raw, AT, S, tid);
#endif
        } else {
#ifndef SKIP_P14
            p14_final(a, vcu, G, wave, lane);
#endif
        }
        if (probe_pass) ++nrep; else { ++ph; nrep = 0; }
        if (ph < 15) { XcdBarrier xb; xb.bar = (unsigned*)(ws + WS_CTL); xb.x = xb_xcc_id(); xb.st = (volatile LAS unsigned*)(lds + LDS_BYTES - 64); int wv3 = wave0; asm volatile("" : "+s"(wv3)); unsigned z3 = 0u; asm volatile("" : "+s"(z3));
                       const bool leader = (wv3 == 0) && (__builtin_amdgcn_mbcnt_hi(~0u, __builtin_amdgcn_mbcnt_lo(~0u, z3)) == 0u);
                       xcd_barrier(xb, leader); }
    }
}

extern "C" void kernel_launch(void* const* d_in, const int* in_sizes, int n_in, void* d_out, int out_size, void* d_ws, size_t ws_size, hipStream_t stream) {
    static int grid = 0;
    if (grid == 0) {
        if (n_in != 22 || out_size != (int)pg8::O_END || ws_size < WS_END) { fprintf(stderr, "kernel_launch: unexpected shapes: n_in %d out %d ws %zu (need %zu)\n", n_in, out_size, ws_size, (size_t)WS_END); grid = -1; return; }
        int dev = 0, cus = 0, per_cu = 0;
        if (hipGetDevice(&dev) != hipSuccess || hipDeviceGetAttribute(&cus, hipDeviceAttributeMultiprocessorCount, dev) != hipSuccess) { grid = -1; return; }
        if (hipFuncSetAttribute((const void*)fwd_kernel, hipFuncAttributeMaxDynamicSharedMemorySize, LDS_BYTES) != hipSuccess) { fprintf(stderr, "kernel_launch: hipFuncSetAttribute failed\n"); grid = -1; return; }
        if (hipOccupancyMaxActiveBlocksPerMultiprocessor(&per_cu, (const void*)fwd_kernel, NWAVES * 64, LDS_BYTES) != hipSuccess || per_cu < 1) { fprintf(stderr, "kernel_launch: occupancy query says %d\n", per_cu); per_cu = 1; }
        (void)hipGetLastError();
        grid = cus;
        if (grid != 256) fprintf(stderr, "kernel_launch: note: %d CUs (attention order assumes 256)\n", grid);
    }
    if (grid < 0) return;
    if (hipMemsetAsync((char*)d_ws + WS_CTL, 0, 32768, stream) != hipSuccess) { fprintf(stderr, "kernel_launch: memset failed\n"); return; }
    Args a{};
    for (int i = 0; i < 22; ++i) a.in[i] = (const float*)d_in[i];
    a.out = (float*)d_out; a.ws = (unsigned char*)d_ws;
    void* args[] = {&a};
    hipError_t e = hipLaunchCooperativeKernel((const void*)fwd_kernel, dim3(grid), dim3(NWAVES * 64), args, LDS_BYTES, stream);
    if (e != hipSuccess) fprintf(stderr, "kernel_launch: cooperative launch failed: %s (grid %d)\n", hipGetErrorString(e), grid);
}
```

```cpp
#include <hip/hip_runtime.h>
#include <hip/hip_cooperative_groups.h>
#include <cstdio>
#include <cstdint>
constexpr int NWAVES = 8;
constexpr int DM = 1024, TP = 8192, MP = 32768, MS = 1024, M = MP + MS, FF = 2816, FF2 = 5632;
constexpr float LOG2E = 1.4426950408889634f;
constexpr size_t MiB = 1u << 20;
constexpr int SSQ_SLOTS = 32;
constexpr size_t SSQ_BYTES = (size_t)M * SSQ_SLOTS * 4;
constexpr size_t WS_SSQ0 = 0, WS_SSQ1 = WS_SSQ0 + SSQ_BYTES, WS_SSQ2 = WS_SSQ1 + SSQ_BYTES, WS_SSQ3 = WS_SSQ2 + SSQ_BYTES, WS_SSQ4 = WS_SSQ3 + SSQ_BYTES;
constexpr size_t WS_LOGF = WS_SSQ4 + SSQ_BYTES;
constexpr size_t WS_CS = WS_LOGF + 3 * MiB;
constexpr size_t WS_TOT = WS_CS + 2 * MiB;
constexpr size_t WS_HALO = WS_TOT + 64 * 1024;
constexpr size_t WS_CTL = 31 * MiB + 512 * 1024;
constexpr size_t QMiB = MiB / 4;
constexpr size_t WS_WAIN = 127 * QMiB, WS_WAOUT = WS_WAIN + 6 * MiB, WS_WUP = WS_WAOUT + 2 * MiB, WS_WDN = WS_WUP + 22 * MiB, WS_WKVQ = WS_WDN + 11 * MiB, WS_WO = WS_WKVQ + 26 * QMiB;
constexpr size_t WS_X = WS_WO + 2 * MiB + QMiB, WS_BIG = WS_X + 66 * MiB, X_BYTES = (size_t)M * DM * 2;
constexpr size_t WS_CU = WS_BIG, WS_GB = WS_BIG + X_BYTES, WS_MB = WS_BIG + 2 * X_BYTES;
constexpr size_t WS_QB = WS_BIG, WS_KB = WS_BIG + X_BYTES, WS_VB = WS_BIG + 2 * X_BYTES;
constexpr size_t WS_UP = WS_BIG, WS_END = WS_BIG + (size_t)M * FF2 * 2;
static_assert(WS_HALO + (size_t)264 * 2 * FF2 * 2 <= WS_CTL && WS_WKVQ + (size_t)3328 * 1024 * 2 <= WS_WO && WS_WDN + (size_t)2 * 1024 * FF * 2 <= WS_WKVQ && WS_END <= 512 * MiB, "ws map");
constexpr int LDS_BYTES = 147456;


namespace pg8 {
#define PG8_LAS __attribute__((address_space(3)))
typedef unsigned short bf16_t;
typedef short bf16x8 __attribute__((ext_vector_type(8)));
typedef float f32x4 __attribute__((ext_vector_type(4)));
typedef unsigned u32x4 __attribute__((ext_vector_type(4)));
constexpr int BM = 256, BK = 64, HALF = 128, HTB = HALF * BK * 2  , STAGE_BYTES = 8 * HTB, NXCD = 8, WGM = 4;

__host__ __device__ __forceinline__ int lds_byte(int r, int c) { const int st = (r >> 4) * 2 + (c >> 5), rr = r & 15, cc = c & 31, ob = rr * 64 + cc * 2; return st * 1024 + (ob ^ (((ob >> 9) & 1) << 5)); }
__host__ __device__ __forceinline__ void stage_rc(int b, int& R, int& C) { const int st = b / 1024, sb = b % 1024, swz = sb ^ (((sb >> 9) & 1) << 5); R = (st >> 1) * 16 + swz / 64; C = (st & 1) * 32 + (swz % 64) / 2; }
__host__ __device__ __forceinline__ int perm32(int rho) { const int n = rho >> 4, i = rho & 15; return 8 * (i >> 2) + 4 * n + (i & 3); }

struct Unit { int pm, pn; };
struct Gemm { const bf16_t* A; const bf16_t* Bt; int M, N, K; int lda; int apair; };

struct StaticOrder {
    int nM, nN, nwg, G, c;
    __host__ __device__ void init(int M, int N, int G_, int c_) { nM = M / BM; nN = N / BM; nwg = nM * nN; G = G_; c = c_; }
    __host__ __device__ bool next(int i, Unit& u) const {
        const long L = (long)i * G + c; if (L >= nwg) return false;
        int wgid = (int)L; { const int q = nwg / NXCD, r = nwg % NXCD, xcd = wgid % NXCD, off = wgid / NXCD; wgid = (xcd < r ? xcd * (q + 1) : r * (q + 1) + (xcd - r) * q) + off; }
        const int nig = WGM * nN, gid = wgid / nig, fm = gid * WGM, gsz = (nM - fm) < WGM ? (nM - fm) : WGM;
        u.pm = fm + ((wgid % nig) % gsz); u.pn = (wgid % nig) / gsz; return true;
    }
    __device__ __forceinline__ void a_ready(const Unit&) const {}
    __device__ __forceinline__ void done(const Unit&) const {}
};

__device__ __forceinline__ unsigned cvt_pk_bf16(float lo, float hi) { unsigned r; asm volatile("v_cvt_pk_bf16_f32 %0, %1, %2" : "=v"(r) : "v"(lo), "v"(hi)); return r; }
#define GAS1 __attribute__((address_space(1)))
constexpr float RMS_EPS = 1e-6f;
constexpr float Q_C2 = 0.125f * 1.4426950408889634f;
constexpr long O_YP = 0, O_YS = 33554432L, O_PCA = O_YS + 1048576L, O_PFC = O_PCA + 8192L, O_PK = O_PFC + 90112L, O_PV = O_PK + 33554432L, O_PLF = O_PV + 33554432L,
               O_SCA = O_PLF + 524288L, O_SFC = O_SCA + 65536L, O_SK = O_SFC + 720896L, O_SV = O_SK + 1048576L, O_SLF = O_SV + 1048576L, O_END = O_SLF + 16384L;
constexpr int MPROMPT = 32768;
__device__ __forceinline__ float row_rs(const float* ssq, int row, int fq) {
    const f32x4 p = *(const GAS1 f32x4*)(ssq + (size_t)row * SSQ_SLOTS + 4 * fq), q = *(const GAS1 f32x4*)(ssq + (size_t)row * SSQ_SLOTS + 16 + 4 * fq);
    float s = ((p[0] + p[1]) + (p[2] + p[3])) + ((q[0] + q[1]) + (q[2] + q[3]));
    s += __shfl_xor(s, 16); s += __shfl_xor(s, 32);
    return __builtin_amdgcn_rsqf(s * (1.0f / 1024.0f) + RMS_EPS);
}
typedef unsigned u32x2 __attribute__((ext_vector_type(2)));
__device__ __forceinline__ u32x2 pack4(const f32x4 v) { u32x2 w; w.x = cvt_pk_bf16(v[0], v[1]); w.y = cvt_pk_bf16(v[2], v[3]); return w; }
__device__ __forceinline__ u32x4 pack8(const f32x4 v0, const f32x4 v1) { u32x4 w; w.x = cvt_pk_bf16(v0[0], v0[1]); w.y = cvt_pk_bf16(v0[2], v0[3]); w.z = cvt_pk_bf16(v1[0], v1[1]); w.w = cvt_pk_bf16(v1[2], v1[3]); return w; }
__device__ __forceinline__ float logsigmoidf(float x) { return x > 0.f ? -log1pf(expf(-x)) : x - log1pf(expf(x)); }
enum EpiMode { EPI_MIX = 0, EPI_RESID = 1, EPI_UP = 2, EPI_KVQ = 3, EPI_NOP = 4, EPI_UP_NOST = 5, EPI_UP_NOLD = 6 };
struct EpiAny {
    static constexpr bool PERM = true, AFTER_DRAIN = false;
    int mode, sel; unsigned char* ws; float* out; const float* b_f;
    __device__ __forceinline__ void operator()(const f32x4 (&acc)[2][2][4][2], const Unit& u, int wr, int wc, int fr_in, int fq_in) const {
        int lane_ = fr_in | (fq_in << 4); asm volatile("" : "+v"(lane_));
        const int fr = lane_ & 15, fq = lane_ >> 4, colw = wc * 32 + 8 * fq;
        unsigned char* ws = this->ws; asm volatile("" : "+s"(ws));
        if (mode == EPI_NOP) {
#pragma unroll
            for (int ai = 0; ai < 2; ++ai)
#pragma unroll
                for (int bj = 0; bj < 2; ++bj)
#pragma unroll
                    for (int m = 0; m < 4; ++m) { asm volatile("" :: "v"(acc[ai][bj][m][0]), "v"(acc[ai][bj][m][1])); }
            return;
        }
        const float* ssq = (const float*)(ws + WS_SSQ0 + (size_t)sel * SSQ_BYTES); GAS1 float* ssq_out = (GAS1 float*)(ws + WS_SSQ0 + (size_t)sel * SSQ_BYTES);
        bf16_t* P0 = (bf16_t*)(ws + (mode == EPI_RESID ? WS_X : WS_BIG));
        bf16_t* P1 = (bf16_t*)(ws + (mode == EPI_UP ? WS_HALO : (mode == EPI_MIX ? WS_GB : WS_VB)));
        if (mode == EPI_KVQ) P0 = (bf16_t*)(ws + WS_KB);
        bf16_t* P2 = (bf16_t*)(ws + WS_QB); float* LOGF = (float*)(ws + WS_LOGF);
        if (mode == EPI_RESID) {
#pragma unroll
            for (int ai = 0; ai < 2; ++ai) {
                u32x4 old[4][2];
#pragma unroll
                for (int m = 0; m < 4; ++m)
#pragma unroll
                    for (int bj = 0; bj < 2; ++bj) old[m][bj] = *(const GAS1 u32x4*)(P0 + (size_t)(u.pm * BM + ai * HALF + wr * 64 + m * 16 + fr) * 1024 + u.pn * BM + bj * HALF + colw);
                asm volatile("" : "+v"(old[0][0]), "+v"(old[0][1]), "+v"(old[1][0]), "+v"(old[1][1]), "+v"(old[2][0]), "+v"(old[2][1]), "+v"(old[3][0]), "+v"(old[3][1]));
#pragma unroll
                for (int m = 0; m < 4; ++m) {
                    const int row = u.pm * BM + ai * HALF + wr * 64 + m * 16 + fr; float ss = 0.f;
#pragma unroll
                    for (int bj = 0; bj < 2; ++bj) {
                        bf16_t* p = P0 + (size_t)row * 1024 + u.pn * BM + bj * HALF + colw;
                        const u32x4 o = old[m][bj];
                        f32x4 r0, r1;
                        r0[0] = __uint_as_float(o.x << 16); r0[1] = __uint_as_float(o.x & 0xffff0000u); r0[2] = __uint_as_float(o.y << 16); r0[3] = __uint_as_float(o.y & 0xffff0000u);
                        r1[0] = __uint_as_float(o.z << 16); r1[1] = __uint_as_float(o.z & 0xffff0000u); r1[2] = __uint_as_float(o.w << 16); r1[3] = __uint_as_float(o.w & 0xffff0000u);
                        const f32x4 v0 = acc[ai][bj][m][0] + r0, v1 = acc[ai][bj][m][1] + r1;
                        ss += (v0[0] * v0[0] + v0[1] * v0[1]) + (v0[2] * v0[2] + v0[3] * v0[3]) + (v1[0] * v1[0] + v1[1] * v1[1]) + (v1[2] * v1[2] + v1[3] * v1[3]);
                        *(u32x4*)p = pack8(v0, v1);
                    }
                    ss += __shfl_xor(ss, 16); ss += __shfl_xor(ss, 32);
                    if (fq < 2) ssq_out[(size_t)row * SSQ_SLOTS + u.pn * 8 + wc * 2 + fq] = fq == 0 ? ss : 0.f;
                }
            }
            return;
        }
        float rs8[2][4];
#pragma unroll
        for (int ai = 0; ai < 2; ++ai)
#pragma unroll
            for (int m = 0; m < 4; ++m) rs8[ai][m] = 1.0f;
        if (mode != EPI_UP) {
            f32x4 pp[2][4], qq[2][4];
#pragma unroll
            for (int ai = 0; ai < 2; ++ai)
#pragma unroll
                for (int m = 0; m < 4; ++m) { const GAS1 float* sp = (const GAS1 float*)ssq + (size_t)(u.pm * BM + ai * HALF + wr * 64 + m * 16 + fr) * SSQ_SLOTS + 4 * fq; pp[ai][m] = *(const GAS1 f32x4*)sp; qq[ai][m] = *(const GAS1 f32x4*)(sp + 16); }
            asm volatile("" : "+v"(pp[0][0]), "+v"(pp[0][1]), "+v"(pp[0][2]), "+v"(pp[0][3]), "+v"(qq[0][0]), "+v"(qq[0][1]), "+v"(qq[0][2]), "+v"(qq[0][3]),
                              "+v"(pp[1][0]), "+v"(pp[1][1]), "+v"(pp[1][2]), "+v"(pp[1][3]), "+v"(qq[1][0]), "+v"(qq[1][1]), "+v"(qq[1][2]), "+v"(qq[1][3]));
#pragma unroll
            for (int ai = 0; ai < 2; ++ai)
#pragma unroll
                for (int m = 0; m < 4; ++m) rs8[ai][m] = ((pp[ai][m][0] + pp[ai][m][1]) + (pp[ai][m][2] + pp[ai][m][3])) + ((qq[ai][m][0] + qq[ai][m][1]) + (qq[ai][m][2] + qq[ai][m][3]));
#pragma unroll
            for (int ai = 0; ai < 2; ++ai)
#pragma unroll
                for (int m = 0; m < 4; ++m) rs8[ai][m] += __shfl_xor(rs8[ai][m], 16);
#pragma unroll
            for (int ai = 0; ai < 2; ++ai)
#pragma unroll
                for (int m = 0; m < 4; ++m) rs8[ai][m] += __shfl_xor(rs8[ai][m], 32);
#pragma unroll
            for (int ai = 0; ai < 2; ++ai)
#pragma unroll
                for (int m = 0; m < 4; ++m) rs8[ai][m] = __builtin_amdgcn_rsqf(rs8[ai][m] * (1.0f / 1024.0f) + RMS_EPS);
        }
#pragma unroll
        for (int ai = 0; ai < 2; ++ai)
#pragma unroll
            for (int m = 0; m < 4; ++m) {
                const int row = u.pm * BM + ai * HALF + wr * 64 + m * 16 + fr;
                const float rs = rs8[ai][m];
                if (mode == EPI_MIX) {
                    if (u.pn < 8) {
                        const f32x4 g0 = acc[ai][0][m][0] * rs, g1 = acc[ai][0][m][1] * rs, u0 = acc[ai][1][m][0] * rs, u1 = acc[ai][1][m][1] * rs;
                        *(GAS1 u32x4*)(P0 + (size_t)row * 1024 + 128 * u.pn + colw) = pack8(g0 * u0, g1 * u1);
                    } else {
#pragma unroll
                        for (int bj = 0; bj < 2; ++bj)
                            *(GAS1 u32x4*)(P1 + (size_t)row * 1024 + 256 * (u.pn - 8) + bj * HALF + colw) = pack8(acc[ai][bj][m][0] * rs, acc[ai][bj][m][1] * rs);
                    }
                } else if (mode == EPI_UP_NOLD) {
                    asm volatile("" :: "v"(rs));
                } else if (mode == EPI_UP_NOST) {
#pragma unroll
                    for (int bj = 0; bj < 2; ++bj) { const u32x4 w = pack8(acc[ai][bj][m][0] * rs, acc[ai][bj][m][1] * rs); asm volatile("" :: "v"(w)); }
                } else if (mode == EPI_UP) {
#pragma unroll
                    for (int bj = 0; bj < 2; ++bj) {
                        const u32x4 w = pack8(acc[ai][bj][m][0] * rs, acc[ai][bj][m][1] * rs);
                        *(GAS1 u32x4*)(P0 + (size_t)row * 5632 + u.pn * BM + bj * HALF + colw) = w;
                        if (wr == 1 && m == 3 && fr >= 14) *(GAS1 u32x4*)(P1 + (size_t)((2 * u.pm + ai) * 2 + (fr - 14)) * 5632 + u.pn * BM + bj * HALF + colw) = w;
                    }
                } else {
                    if (u.pn < 8) {
                        const int kv = u.pn >> 2, cb = 256 * (u.pn & 3);
                        bf16_t* db = (kv ? P1 : P0) + (size_t)row * 1024 + cb + colw;
                        float* df = (row < MPROMPT) ? out + (kv ? O_PV : O_PK) + (size_t)row * 1024 + cb + colw : out + (kv ? O_SV : O_SK) + (size_t)(row - MPROMPT) * 1024 + cb + colw;
#pragma unroll
                        for (int bj = 0; bj < 2; ++bj) {
                            const f32x4 v0 = acc[ai][bj][m][0] * rs, v1 = acc[ai][bj][m][1] * rs;
                            *(GAS1 u32x4*)(db + bj * HALF) = pack8(v0, v1);
                            __builtin_nontemporal_store(v0, (GAS1 f32x4*)(df + bj * HALF)); __builtin_nontemporal_store(v1, (GAS1 f32x4*)(df + bj * HALF + 4));
                        }
                    } else if (u.pn < 12) {
#pragma unroll
                        for (int bj = 0; bj < 2; ++bj)
                            *(GAS1 u32x4*)(P2 + (size_t)row * 1024 + 256 * (u.pn - 8) + bj * HALF + colw) = pack8(acc[ai][bj][m][0] * (rs * Q_C2), acc[ai][bj][m][1] * (rs * Q_C2));
                    } else if (wc == 0 && fq < 2) {
                        f32x4 v0 = acc[ai][0][m][0] * rs, v1 = acc[ai][0][m][1] * rs;
                        const f32x4 b0 = *(const GAS1 f32x4*)(b_f + 8 * fq), b1 = *(const GAS1 f32x4*)(b_f + 8 * fq + 4);
#pragma unroll
                        for (int e = 0; e < 4; ++e) { v0[e] = logsigmoidf(v0[e] + b0[e]); v1[e] = logsigmoidf(v1[e] + b1[e]); }
                        *(GAS1 f32x4*)(LOGF + (size_t)row * 16 + 8 * fq) = v0; *(GAS1 f32x4*)(LOGF + (size_t)row * 16 + 8 * fq + 4) = v1;
                        float* df = (row < MPROMPT) ? out + O_PLF + (size_t)row * 16 + 8 * fq : out + O_SLF + (size_t)(row - MPROMPT) * 16 + 8 * fq;
                        *(f32x4*)df = v0; *(GAS1 f32x4*)(df + 4) = v1;
                    }
                }
            }
    }

    __device__ __forceinline__ void small(const f32x4 (&acc)[2][4], int row0, int pn, int w, int fr, int fq) const {
        const int colw = 16 * w + 4 * fq;
        const float* ssq = (const float*)(ws + WS_SSQ0 + (size_t)sel * SSQ_BYTES); GAS1 float* ssq_out = (GAS1 float*)(ws + WS_SSQ0 + (size_t)sel * SSQ_BYTES);
        if (mode == EPI_NOP) {
#pragma unroll
            for (int bj = 0; bj < 2; ++bj)
#pragma unroll
                for (int m = 0; m < 4; ++m) { asm volatile("" :: "v"(acc[bj][m])); }
            return;
        }
        if (mode == EPI_RESID) {
            bf16_t* X = (bf16_t*)(ws + WS_X);
            u32x2 old[4][2];
#pragma unroll
            for (int m = 0; m < 4; ++m)
#pragma unroll
                for (int bj = 0; bj < 2; ++bj) old[m][bj] = *(const GAS1 u32x2*)(X + (size_t)(row0 + 16 * m + fr) * 1024 + pn * BM + bj * HALF + colw);
#pragma unroll
            for (int m = 0; m < 4; ++m) {
                const int row = row0 + 16 * m + fr; float ss = 0.f;
#pragma unroll
                for (int bj = 0; bj < 2; ++bj) {
                    bf16_t* p = X + (size_t)row * 1024 + pn * BM + bj * HALF + colw;
                    const u32x2 o = old[m][bj]; f32x4 r;
                    r[0] = __uint_as_float(o.x << 16); r[1] = __uint_as_float(o.x & 0xffff0000u); r[2] = __uint_as_float(o.y << 16); r[3] = __uint_as_float(o.y & 0xffff0000u);
                    const f32x4 v = acc[bj][m] + r;
                    ss += (v[0] * v[0] + v[1] * v[1]) + (v[2] * v[2] + v[3] * v[3]);
                    *(u32x2*)p = pack4(v);
                }
                ss += __shfl_xor(ss, 16); ss += __shfl_xor(ss, 32);
                if (fq == 0) ssq_out[(size_t)row * SSQ_SLOTS + pn * 8 + w] = ss;
            }
            return;
        }
        float rs4[4];
        {
            f32x4 pp[4], qq[4];
#pragma unroll
            for (int m = 0; m < 4; ++m) { const GAS1 float* sp = (const GAS1 float*)ssq + (size_t)(row0 + 16 * m + fr) * SSQ_SLOTS + 4 * fq; pp[m] = *(const GAS1 f32x4*)sp; qq[m] = *(const GAS1 f32x4*)(sp + 16); }
            asm volatile("" : "+v"(pp[0]), "+v"(pp[1]), "+v"(pp[2]), "+v"(pp[3]), "+v"(qq[0]), "+v"(qq[1]), "+v"(qq[2]), "+v"(qq[3]));
#pragma unroll
            for (int m = 0; m < 4; ++m) rs4[m] = ((pp[m][0] + pp[m][1]) + (pp[m][2] + pp[m][3])) + ((qq[m][0] + qq[m][1]) + (qq[m][2] + qq[m][3]));
#pragma unroll
            for (int m = 0; m < 4; ++m) rs4[m] += __shfl_xor(rs4[m], 16);
#pragma unroll
            for (int m = 0; m < 4; ++m) rs4[m] += __shfl_xor(rs4[m], 32);
#pragma unroll
            for (int m = 0; m < 4; ++m) rs4[m] = __builtin_amdgcn_rsqf(rs4[m] * (1.0f / 1024.0f) + RMS_EPS);
        }
#pragma unroll
        for (int m = 0; m < 4; ++m) {
            const int row = row0 + 16 * m + fr;
            const float rs = rs4[m];
            if (mode == EPI_MIX) {
                if (pn < 8) *(GAS1 u32x2*)((bf16_t*)(ws + WS_CU) + (size_t)row * 1024 + 128 * pn + colw) = pack4((acc[0][m] * rs) * (acc[1][m] * rs));
                else {
#pragma unroll
                    for (int bj = 0; bj < 2; ++bj) *(GAS1 u32x2*)((bf16_t*)(ws + WS_GB) + (size_t)row * 1024 + 256 * (pn - 8) + bj * HALF + colw) = pack4(acc[bj][m] * rs);
                }
            } else if (mode == EPI_UP) {
#pragma unroll
                for (int bj = 0; bj < 2; ++bj) *(GAS1 u32x2*)((bf16_t*)(ws + WS_UP) + (size_t)row * 5632 + pn * BM + bj * HALF + colw) = pack4(acc[bj][m] * rs);
            } else {
                if (pn < 8) {
                    const int kv = pn >> 2, cb = 256 * (pn & 3);
                    bf16_t* db = (bf16_t*)(ws + (kv ? WS_VB : WS_KB)) + (size_t)row * 1024 + cb + colw;
                    float* df = (row < MPROMPT) ? out + (kv ? O_PV : O_PK) + (size_t)row * 1024 + cb + colw : out + (kv ? O_SV : O_SK) + (size_t)(row - MPROMPT) * 1024 + cb + colw;
#pragma unroll
                    for (int bj = 0; bj < 2; ++bj) { const f32x4 v = acc[bj][m] * rs; *(GAS1 u32x2*)(db + bj * HALF) = pack4(v); *(GAS1 f32x4*)(df + bj * HALF) = v; }
                } else if (pn < 12) {
#pragma unroll
                    for (int bj = 0; bj < 2; ++bj) *(GAS1 u32x2*)((bf16_t*)(ws + WS_QB) + (size_t)row * 1024 + 256 * (pn - 8) + bj * HALF + colw) = pack4(acc[bj][m] * (rs * Q_C2));
                } else if (w == 0) {
                    f32x4 v = acc[0][m] * rs; const f32x4 b0 = *(const GAS1 f32x4*)(b_f + 4 * fq);
#pragma unroll
                    for (int e = 0; e < 4; ++e) v[e] = logsigmoidf(v[e] + b0[e]);
                    *(GAS1 f32x4*)((float*)(ws + WS_LOGF) + (size_t)row * 16 + 4 * fq) = v;
                    float* df = (row < MPROMPT) ? out + O_PLF + (size_t)row * 16 + 4 * fq : out + O_SLF + (size_t)(row - MPROMPT) * 16 + 4 * fq;
                    *(f32x4*)df = v;
                }
            }
        }
    }
};

template <class Epi, class Sched, bool ALIGN_EPI = false, bool SP2 = false>
__device__ __forceinline__ void gemm_phase(PG8_LAS unsigned char* lds, const Gemm g, const Sched& S, const Epi& E, const int tid) {
    const int wid = __builtin_amdgcn_readfirstlane(tid >> 6), lane = tid & 63, wr = wid >> 2, wc = wid & 3, fr = lane & 15, fq = lane >> 4;
    const int K = g.K, nt = K / BK;
    unsigned voffA[2], voffB[2];
#pragma unroll
    for (int i = 0; i < 2; ++i) { int R, C; stage_rc(tid * 16 + i * 8192, R, C); const int Rb = Epi::PERM ? ((R & ~31) + perm32(R & 31)) : R;
        voffA[i] = (unsigned)(R * g.lda + C) * 2u; voffB[i] = (unsigned)(Rb * K + C) * 2u; }
    const size_t kstep = (size_t)(BK * 2);
    const unsigned hstepB = (unsigned)HALF * K * 2, hstepA = (unsigned)HALF * g.lda * 2;
    const unsigned tstepB = 2 * hstepB, tstepA = 2 * hstepA;
    const unsigned ldsw = (unsigned)wid * 1024u;
    const int aoff = lds_byte(wr * 64 + fr, fq * 8), boff = lds_byte(wc * 32 + fr, fq * 8);
#define PG8_SA(b, h) (((b) * 2 + (h)) * HTB)
#define PG8_SB(b, h) ((4 + (b) * 2 + (h)) * HTB)
#define PG8_STAGE(bufoff, gbase, voff) do { _Pragma("unroll") for (int _i = 0; _i < 2; ++_i) \
        __builtin_amdgcn_global_load_lds((const unsigned*)((const char*)(gbase) + (voff)[_i]), (PG8_LAS unsigned*)(lds + (bufoff) + ldsw + _i * 8192), 16, 0, 0); } while (0)
#define PG8_LDA(dst, b, h) do { _Pragma("unroll") for (int m = 0; m < 4; ++m) _Pragma("unroll") for (int k = 0; k < 2; ++k) dst[m][k] = *(const PG8_LAS bf16x8*)(lds + PG8_SA(b, h) + aoff + m * 2048 + k * 1024); } while (0)
#define PG8_LDB(dst, b, h) do { _Pragma("unroll") for (int n = 0; n < 2; ++n) _Pragma("unroll") for (int k = 0; k < 2; ++k) dst[n][k] = *(const PG8_LAS bf16x8*)(lds + PG8_SB(b, h) + boff + n * 2048 + k * 1024); } while (0)
#define PG8_MMA(ai, bj, At, Bt) do { __builtin_amdgcn_s_setprio(1); _Pragma("unroll") for (int m = 0; m < 4; ++m) _Pragma("unroll") for (int n = 0; n < 2; ++n) _Pragma("unroll") for (int k = 0; k < 2; ++k) \
        acc[ai][bj][m][n] = __builtin_amdgcn_mfma_f32_16x16x32_bf16(Bt[n][k], At[m][k], acc[ai][bj][m][n], 0, 0, 0); __builtin_amdgcn_s_setprio(0); } while (0)
#define PG8_WAIT_V(n) asm volatile("s_waitcnt vmcnt(" #n ")" ::: "memory")
#define PG8_WAIT_L(n) asm volatile("s_waitcnt lgkmcnt(" #n ")" ::: "memory")
#define PG8_BAR __builtin_amdgcn_s_barrier()
#define PG8_SCHED __builtin_amdgcn_sched_barrier(0)
    Unit cur, nxt; int ui = 0;
    if (!S.next(0, cur)) return;
    f32x4 acc[2][2][4][2];
#pragma unroll
    for (int a = 0; a < 2; ++a)
#pragma unroll
        for (int b = 0; b < 2; ++b)
#pragma unroll
            for (int m = 0; m < 4; ++m)
#pragma unroll
                for (int n = 0; n < 2; ++n) acc[a][b][m][n] = (f32x4){0.f, 0.f, 0.f, 0.f};
    bf16x8 At[4][2], B0[2][2], B1[2][2];
    const char* cA = (const char*)g.A + (size_t)cur.pm * tstepA; const char* cB = (const char*)g.Bt + (size_t)cur.pn * tstepB;
    S.a_ready(cur);
    if constexpr (SP2) {
        PG8_STAGE(PG8_SB(0, 0), cB, voffB); PG8_STAGE(PG8_SB(0, 1), cB + hstepB, voffB); PG8_STAGE(PG8_SA(0, 0), cA, voffA); PG8_STAGE(PG8_SA(0, 1), cA + hstepA, voffA);
        if (wr == 1) PG8_BAR;
        PG8_WAIT_V(2); PG8_BAR;
        PG8_STAGE(PG8_SB(1, 0), cB + kstep, voffB); PG8_STAGE(PG8_SA(1, 0), cA + kstep, voffA); PG8_STAGE(PG8_SB(1, 1), cB + hstepB + kstep, voffB);
        PG8_WAIT_V(6); PG8_BAR;
    } else {
        PG8_STAGE(PG8_SB(0, 0), cB, voffB); PG8_STAGE(PG8_SA(0, 0), cA, voffA); PG8_STAGE(PG8_SB(0, 1), cB + hstepB, voffB); PG8_STAGE(PG8_SA(0, 1), cA + hstepA, voffA);
        if (wr == 1) PG8_BAR;
        PG8_WAIT_V(4); PG8_BAR;
        PG8_STAGE(PG8_SB(1, 0), cB + kstep, voffB); PG8_STAGE(PG8_SA(1, 0), cA + kstep, voffA); PG8_STAGE(PG8_SB(1, 1), cB + hstepB + kstep, voffB);
        PG8_WAIT_V(6); PG8_BAR;
    }
    for (;;) {
        const bool has_next = S.next(ui + 1, nxt);
        const char* nA = has_next ? (const char*)g.A + (size_t)nxt.pm * tstepA : cA; const char* nB = has_next ? (const char*)g.Bt + (size_t)nxt.pn * tstepB : cB;
        for (int t = 0; t < nt; t += 2) {
            const bool last = (t == nt - 2);
            const char* a1 = cA + (unsigned)(t >> 1) * (unsigned)g.apair + 128u;
            const char* a2 = last ? nA : cA + (unsigned)((t >> 1) + 1) * (unsigned)g.apair; const char* b2 = last ? nB : cB + (size_t)(t + 2) * kstep;
            const char* a3 = a2 + kstep; const char* b3 = b2 + kstep;
            if (last && has_next) S.a_ready(nxt);
            if constexpr (SP2) {
            PG8_LDB(B0, 0, 0); PG8_LDB(B1, 0, 1); PG8_SCHED; PG8_LDA(At, 0, 0); PG8_STAGE(PG8_SA(1, 1), a1 + hstepA, voffA);
            PG8_WAIT_V(8); PG8_WAIT_L(0); PG8_BAR; PG8_MMA(0, 0, At, B0); PG8_MMA(0, 1, At, B1); PG8_BAR; PG8_SCHED;
            PG8_LDA(At, 0, 1); PG8_STAGE(PG8_SB(0, 0), b2, voffB); PG8_STAGE(PG8_SB(0, 1), b2 + hstepB, voffB); PG8_STAGE(PG8_SA(0, 0), a2, voffA);
            PG8_WAIT_V(8); PG8_WAIT_L(0); PG8_BAR; PG8_MMA(1, 0, At, B0); PG8_MMA(1, 1, At, B1); PG8_BAR; PG8_SCHED;
            PG8_LDB(B0, 1, 0); PG8_LDB(B1, 1, 1); PG8_SCHED; PG8_LDA(At, 1, 0); PG8_STAGE(PG8_SA(0, 1), a2 + hstepA, voffA);
            PG8_WAIT_V(8); PG8_WAIT_L(0); PG8_BAR; PG8_MMA(0, 0, At, B0); PG8_MMA(0, 1, At, B1); PG8_BAR; PG8_SCHED;
            PG8_LDA(At, 1, 1); PG8_STAGE(PG8_SB(1, 0), b3, voffB); PG8_STAGE(PG8_SB(1, 1), b3 + hstepB, voffB); PG8_STAGE(PG8_SA(1, 0), a3, voffA);
            PG8_WAIT_V(8); PG8_WAIT_L(0); PG8_BAR; PG8_MMA(1, 0, At, B0); PG8_MMA(1, 1, At, B1); PG8_BAR; PG8_SCHED;
            } else {
            PG8_LDB(B0, 0, 0); PG8_SCHED; PG8_LDA(At, 0, 0); PG8_STAGE(PG8_SA(1, 1), a1 + hstepA, voffA);
            PG8_WAIT_L(8); PG8_BAR; PG8_WAIT_L(0); PG8_MMA(0, 0, At, B0); PG8_BAR; PG8_SCHED;
            PG8_LDB(B1, 0, 1); PG8_STAGE(PG8_SB(0, 0), b2, voffB);
            PG8_BAR; PG8_WAIT_L(0); PG8_MMA(0, 1, At, B1); PG8_BAR;
            PG8_LDA(At, 0, 1); PG8_STAGE(PG8_SA(0, 0), a2, voffA);
            PG8_BAR; PG8_WAIT_L(0); PG8_MMA(1, 0, At, B0); PG8_BAR; PG8_SCHED;
            PG8_STAGE(PG8_SB(0, 1), b2 + hstepB, voffB);
            PG8_WAIT_V(6); PG8_BAR; PG8_MMA(1, 1, At, B1); PG8_BAR;
            PG8_LDB(B0, 1, 0); PG8_SCHED; PG8_LDA(At, 1, 0); PG8_STAGE(PG8_SA(0, 1), a2 + hstepA, voffA);
            PG8_WAIT_L(8); PG8_BAR; PG8_WAIT_L(0); PG8_MMA(0, 0, At, B0); PG8_BAR; PG8_SCHED;
            PG8_LDB(B1, 1, 1); PG8_STAGE(PG8_SB(1, 0), b3, voffB);
            PG8_BAR; PG8_WAIT_L(0); PG8_MMA(0, 1, At, B1); PG8_BAR;
            PG8_LDA(At, 1, 1); PG8_STAGE(PG8_SA(1, 0), a3, voffA);
            PG8_BAR; PG8_WAIT_L(0); PG8_MMA(1, 0, At, B0); PG8_BAR; PG8_SCHED;
            PG8_STAGE(PG8_SB(1, 1), b3 + hstepB, voffB);
            PG8_WAIT_V(6); PG8_BAR; PG8_MMA(1, 1, At, B1); PG8_BAR;
            }
        }
        if constexpr (ALIGN_EPI) { if (wr == 0) PG8_BAR; }
        if constexpr (!Epi::AFTER_DRAIN) { E(acc, cur, wr, wc, fr, fq); S.done(cur); }
        if (!has_next) break;
#pragma unroll
        for (int a = 0; a < 2; ++a)
#pragma unroll
            for (int b = 0; b < 2; ++b)
#pragma unroll
                for (int m = 0; m < 4; ++m)
#pragma unroll
                    for (int n = 0; n < 2; ++n) acc[a][b][m][n] = (f32x4){0.f, 0.f, 0.f, 0.f};
        cur = nxt; cA = nA; cB = nB; ++ui;
        if constexpr (ALIGN_EPI) { if (wr == 1) PG8_BAR; }
    }
    PG8_WAIT_V(0);
    if constexpr (!ALIGN_EPI) { if (wr == 0) PG8_BAR; }
    PG8_BAR;
    if constexpr (Epi::AFTER_DRAIN) { E.fused(acc, cur, wr, wc, fr, fq, lds, wid, lane); S.done(cur); }
#undef PG8_SA
#undef PG8_SB
#undef PG8_STAGE
#undef PG8_LDA
#undef PG8_LDB
#undef PG8_MMA
#undef PG8_WAIT_V
#undef PG8_WAIT_L
#undef PG8_BAR
#undef PG8_SCHED
}
}
namespace pg8 {
constexpr int SM_STAGE = 40960;
template <class Epi>
__device__ __forceinline__ void gemm_small(PG8_LAS unsigned char* lds, const Gemm g, const int row_base, const int n_rt, const int vcu, const int G, const Epi& E, const int tid) {
    const int wid = __builtin_amdgcn_readfirstlane(tid >> 6), lane = tid & 63, fr = lane & 15, fq = lane >> 4;
    const int K = g.K, nt = K / BK, nN = g.N / BM;
    int R0, C0, R1, C1; stage_rc(tid * 16, R0, C0); stage_rc(tid * 16 + 8192, R1, C1);
    const unsigned voffA = (unsigned)(R0 * g.lda + C0) * 2u, voffB0 = (unsigned)(R0 * K + C0) * 2u, voffB1 = (unsigned)(R1 * K + C1) * 2u;
    const unsigned hB = (unsigned)HALF * K * 2u, ldsw = (unsigned)wid * 1024u;
    const int aoff = lds_byte(fr, fq * 8), boff = 8192 + lds_byte(wid * 16 + fr, fq * 8);
#define SM_GLDS(src, dst) __builtin_amdgcn_global_load_lds((const unsigned*)(src), (PG8_LAS unsigned*)(dst), 16, 0, 0)
#define SM_STAGE_TILE(t, s) do { const char* a_ = pA + (unsigned)((t) >> 1) * (unsigned)g.apair + (unsigned)((t) & 1) * 128u; const char* b_ = pB + (unsigned)(t) * 128u; PG8_LAS unsigned char* d_ = lds + (s) * SM_STAGE + ldsw; \
        SM_GLDS(a_ + voffA, d_); SM_GLDS(b_ + voffB0, d_ + 8192); SM_GLDS(b_ + voffB1, d_ + 16384); SM_GLDS(b_ + hB + voffB0, d_ + 24576); SM_GLDS(b_ + hB + voffB1, d_ + 32768); } while (0)
    for (int u = vcu; u < n_rt * nN; u += G) {
        const int pn = u / n_rt, rt = u % n_rt;
        const char* pA = (const char*)g.A + (size_t)(row_base + 64 * rt) * g.lda * 2;
        const char* pB = (const char*)g.Bt + (size_t)(256 * pn) * K * 2;
        f32x4 acc[2][4];
#pragma unroll
        for (int b = 0; b < 2; ++b)
#pragma unroll
            for (int m = 0; m < 4; ++m) acc[b][m] = (f32x4){0.f, 0.f, 0.f, 0.f};
        SM_STAGE_TILE(0, 0); SM_STAGE_TILE(1, 1);
        int s = 0, s2 = 2;
#pragma unroll 1
        for (int t = 0; t < nt; ++t) {
            if (t + 1 < nt) asm volatile("s_waitcnt vmcnt(5)" ::: "memory"); else asm volatile("s_waitcnt vmcnt(0)" ::: "memory");
            asm volatile("s_waitcnt lgkmcnt(0)" ::: "memory"); __builtin_amdgcn_s_barrier(); asm volatile("" ::: "memory");
            if (t + 2 < nt) SM_STAGE_TILE(t + 2, s2);
            bf16x8 Af[4][2], Bf[2][2];
            PG8_LAS unsigned char* sb = lds + s * SM_STAGE;
#pragma unroll
            for (int m = 0; m < 4; ++m)
#pragma unroll
                for (int k = 0; k < 2; ++k) Af[m][k] = *(const PG8_LAS bf16x8*)(sb + aoff + m * 2048 + k * 1024);
#pragma unroll
            for (int b = 0; b < 2; ++b)
#pragma unroll
                for (int k = 0; k < 2; ++k) Bf[b][k] = *(const PG8_LAS bf16x8*)(sb + boff + b * 16384 + k * 1024);
#pragma unroll
            for (int k = 0; k < 2; ++k)
#pragma unroll
                for (int b = 0; b < 2; ++b)
#pragma unroll
                    for (int m = 0; m < 4; ++m) acc[b][m] = __builtin_amdgcn_mfma_f32_16x16x32_bf16(Bf[b][k], Af[m][k], acc[b][m], 0, 0, 0);
            s = (s == 2) ? 0 : s + 1; s2 = (s2 == 2) ? 0 : s2 + 1;
        }
        asm volatile("s_waitcnt lgkmcnt(0)" ::: "memory"); __builtin_amdgcn_s_barrier(); asm volatile("" ::: "memory");
        E.small(acc, row_base + 64 * rt, pn, wid, fr, fq);
    }
#undef SM_GLDS
#undef SM_STAGE_TILE
}

constexpr int S64_STAGE = 16384, S64_NST = 7, S64_SCR = S64_STAGE * S64_NST;
__device__ __forceinline__ void gemm_small64_resid(PG8_LAS unsigned char* lds, const Gemm g, const int row_base, const int vcu, const int G, unsigned char* ws, const int sel, const int tid, const bool nop) {
    const int wid = __builtin_amdgcn_readfirstlane(tid >> 6), lane = tid & 63, fr = lane & 15, fq = lane >> 4, wr = wid >> 2, wc = wid & 3;
    const int K = g.K, nt = K / BK, nN = g.N / 64, n_rt = 16;
    int R0, C0; stage_rc(tid * 16, R0, C0);
    const unsigned voffA = (unsigned)(R0 * g.lda + C0) * 2u, voffB = (unsigned)(R0 * K + C0) * 2u, ldsw = (unsigned)wid * 1024u;
    const int aoff = lds_byte(32 * wr + fr, fq * 8), boff = 8192 + lds_byte(16 * wc + fr, fq * 8);
#define S64_GLDS(src, dst) __builtin_amdgcn_global_load_lds((const unsigned*)(src), (PG8_LAS unsigned*)(dst), 16, 0, 0)
#define S64_STAGE_TILE(t, s) do { const char* a_ = pA + (unsigned)((t) >> 1) * (unsigned)g.apair + (unsigned)((t) & 1) * 128u; const char* b_ = pB + (unsigned)(t) * 128u; PG8_LAS unsigned char* d_ = lds + (s) * S64_STAGE + ldsw; \
        S64_GLDS(a_ + voffA, d_); S64_GLDS(b_ + voffB, d_ + 8192); } while (0)
    for (int u = vcu; u < n_rt * nN; u += G) {
        const int pn = u / n_rt, rt = u % n_rt, row0 = row_base + 64 * rt;
        const char* pA = (const char*)g.A + (size_t)row0 * g.lda * 2;
        const char* pB = (const char*)g.Bt + (size_t)(64 * pn) * K * 2;
        f32x4 acc[2]; acc[0] = (f32x4){0.f, 0.f, 0.f, 0.f}; acc[1] = (f32x4){0.f, 0.f, 0.f, 0.f};
#pragma unroll
        for (int t = 0; t < S64_NST - 1; ++t) S64_STAGE_TILE(t, t);
        int s = 0, s2 = S64_NST - 1;
#pragma unroll 1
        for (int t = 0; t < nt; ++t) {
            const int rem = nt - 1 - t;
            if (rem >= 5) asm volatile("s_waitcnt vmcnt(10)" ::: "memory"); else if (rem == 4) asm volatile("s_waitcnt vmcnt(8)" ::: "memory"); else if (rem == 3) asm volatile("s_waitcnt vmcnt(6)" ::: "memory");
            else if (rem == 2) asm volatile("s_waitcnt vmcnt(4)" ::: "memory"); else if (rem == 1) asm volatile("s_waitcnt vmcnt(2)" ::: "memory"); else asm volatile("s_waitcnt vmcnt(0)" ::: "memory");
            asm volatile("s_waitcnt lgkmcnt(0)" ::: "memory"); __builtin_amdgcn_s_barrier(); asm volatile("" ::: "memory");
            if (t + S64_NST - 1 < nt) S64_STAGE_TILE(t + S64_NST - 1, s2);
            PG8_LAS unsigned char* sb = lds + s * S64_STAGE;
            bf16x8 Af[2][2], Bf[2];
#pragma unroll
            for (int m = 0; m < 2; ++m)
#pragma unroll
                for (int k = 0; k < 2; ++k) Af[m][k] = *(const PG8_LAS bf16x8*)(sb + aoff + m * 2048 + k * 1024);
#pragma unroll
            for (int k = 0; k < 2; ++k) Bf[k] = *(const PG8_LAS bf16x8*)(sb + boff + k * 1024);
#pragma unroll
            for (int k = 0; k < 2; ++k)
#pragma unroll
                for (int m = 0; m < 2; ++m) acc[m] = __builtin_amdgcn_mfma_f32_16x16x32_bf16(Bf[k], Af[m][k], acc[m], 0, 0, 0);
            s = (s == S64_NST - 1) ? 0 : s + 1; s2 = (s2 == S64_NST - 1) ? 0 : s2 + 1;
        }
        if (nop) { asm volatile("" :: "v"(acc[0]), "v"(acc[1])); asm volatile("s_waitcnt lgkmcnt(0)" ::: "memory"); __builtin_amdgcn_s_barrier(); continue; }
        PG8_LAS float* scr = (PG8_LAS float*)(lds + S64_SCR);
        bf16_t* X = (bf16_t*)(ws + WS_X); GAS1 float* ssq_out = (GAS1 float*)(ws + WS_SSQ0 + (size_t)sel * SSQ_BYTES);
        u32x2 old2[2];
#pragma unroll
        for (int m = 0; m < 2; ++m) old2[m] = *(const GAS1 u32x2*)(X + (size_t)(row0 + 32 * wr + 16 * m + fr) * 1024 + 64 * pn + 16 * wc + 4 * fq);
#pragma unroll
        for (int m = 0; m < 2; ++m) {
            const int rl = 32 * wr + 16 * m + fr, row = row0 + rl;
            bf16_t* p = X + (size_t)row * 1024 + 64 * pn + 16 * wc + 4 * fq;
            const u32x2 o = old2[m]; f32x4 r;
            r[0] = __uint_as_float(o.x << 16); r[1] = __uint_as_float(o.x & 0xffff0000u); r[2] = __uint_as_float(o.y << 16); r[3] = __uint_as_float(o.y & 0xffff0000u);
            const f32x4 v = acc[m] + r;
            float ss = (v[0] * v[0] + v[1] * v[1]) + (v[2] * v[2] + v[3] * v[3]);
            *(u32x2*)p = pack4(v);
            ss += __shfl_xor(ss, 16); ss += __shfl_xor(ss, 32);
            if (fq == 0) scr[rl * 4 + wc] = ss;
        }
        asm volatile("s_waitcnt lgkmcnt(0)" ::: "memory"); __builtin_amdgcn_s_barrier(); asm volatile("" ::: "memory");
        if (tid < 128) { const int rl = tid >> 1, hf = tid & 1; ssq_out[(size_t)(row0 + rl) * SSQ_SLOTS + pn * 2 + hf] = scr[rl * 4 + 2 * hf] + scr[rl * 4 + 2 * hf + 1]; }
    }
#undef S64_GLDS
#undef S64_STAGE_TILE
}
}

#define PG8_SP2 true
#define PG8_ALIGN true
#define ATTN_STORE16(p,v) (*(__attribute__((address_space(1))) attn_u32x4_t*)(p)=(v))
typedef unsigned attn_u32x4_t __attribute__((ext_vector_type(4)));
#include <hip/hip_bf16.h>
#include <cmath>
namespace attn_body {
using bf16=__hip_bfloat16;
using bf16x8=__attribute__((ext_vector_type(8)))short;
using s16x4=__attribute__((ext_vector_type(4)))short;
using f32x16=__attribute__((ext_vector_type(16)))float;
using u32x4=__attribute__((ext_vector_type(4)))unsigned;
using f32x4_t=__attribute__((ext_vector_type(4)))float;
constexpr int BATCH=4,NHEAD=16,SEQ=8192,D=64,DM=NHEAD*D;
constexpr int NW=8,QBLK=32,QB=QBLK*NW,KVBLK=64,NQB=SEQ/QB;
constexpr int ATTN_PITCH=DM, ATTN_UNIT_ROWS=QB;
__device__ __forceinline__ int crow(int r,int hi){return (r&3)+8*(r>>2)+4*hi;}
#define SBAR() __builtin_amdgcn_sched_barrier(0)
__device__ __forceinline__ void cmask(f32x16&p0,f32x16&p1,int jb,int qrel,int hi){
  const float NEG=-INFINITY; int kb=64*jb+4*hi;
  #pragma unroll
  for(int r=0;r<16;++r){int kv=kb+(r&3)+8*(r>>2); if(kv>qrel)p0[r]=NEG; if(kv+32>qrel)p1[r]=NEG;}
}

constexpr int NSLOT=3, SLOTB=8192;
constexpr int LDS_K=0, LDS_V=NSLOT*SLOTB, LDS_WS=2*NSLOT*SLOTB, LDS_OST=LDS_WS+NW*64*4, LDS_BIAS=LDS_OST+NW*4096, LDS_BYTES=LDS_BIAS+SEQ*4;
constexpr float C2=0.125f*1.4426950408889634f;
__device__ __forceinline__ void glds16(const void*gsrc,unsigned lds_dst){unsigned keep;
  asm volatile("s_mov_b32 %0, m0\n\ts_mov_b32 m0, %2\n\ts_nop 0\n\tglobal_load_lds_dwordx4 %1, off\n\ts_mov_b32 m0, %0":"=&s"(keep):"v"(gsrc),"s"(lds_dst):"memory");}
__device__ __forceinline__ float max3f(float a,float b,float c){float r;asm("v_max3_f32 %0, %1, %2, %3":"=v"(r):"v"(a),"v"(b),"v"(c));return r;}
__device__ __forceinline__ float max2f(float a,float b){float r;asm("v_max_f32_e32 %0, %1, %2":"=v"(r):"v"(a),"v"(b));return r;}
__device__ __forceinline__ float fadd_s(float a,float b){float r;asm("v_add_f32_e32 %0, %1, %2":"=v"(r):"v"(a),"v"(b));return r;}
__device__ __forceinline__ float fsub_s(float a,float b){float r;asm("v_sub_f32_e32 %0, %1, %2":"=v"(r):"v"(a),"v"(b));return r;}
typedef float f32x2_t __attribute__((ext_vector_type(2))); typedef __bf16 bf16x2_t __attribute__((ext_vector_type(2)));
__device__ __forceinline__ unsigned cvtpk_s(float lo,float hi){f32x2_t v={lo,hi};bf16x2_t b=__builtin_convertvector(v,bf16x2_t);return __builtin_bit_cast(unsigned,b);}
#define WAIT_BAR(N) asm volatile("s_waitcnt vmcnt(" #N ") lgkmcnt(0)\n\ts_barrier":::"memory")

__device__ __forceinline__ void qkt(f32x16&p0,f32x16&p1,const char*Kslot,const bf16x8*qr,int r32,int hi,const bf16x8 ab0,const bf16x8 ab1,const bf16x8 qb){
  p0=__builtin_amdgcn_mfma_f32_32x32x16_bf16(ab0,qb,f32x16{},0,0,0);p1=__builtin_amdgcn_mfma_f32_32x32x16_bf16(ab1,qb,f32x16{},0,0,0);
  const char*kb=Kslot+hi*1024+r32*16;
  #pragma unroll
  for(int d0=0;d0<4;++d0){
    const bf16x8 b0=*reinterpret_cast<const bf16x8*>(kb+d0*2048);
    const bf16x8 b1=*reinterpret_cast<const bf16x8*>(kb+d0*2048+512);
    {p0=__builtin_amdgcn_mfma_f32_32x32x16_bf16(b0,qr[d0],p0,0,0,0);p1=__builtin_amdgcn_mfma_f32_32x32x16_bf16(b1,qr[d0],p1,0,0,0);}}
}
typedef __attribute__((address_space(3))) const char* lds_cptr;
typedef short v4i16_t __attribute__((ext_vector_type(4)));
__device__ __forceinline__ void kload8(bf16x8*kf,lds_cptr kp){
  kf[0]=*(const __attribute__((address_space(3))) bf16x8*)(kp);      kf[1]=*(const __attribute__((address_space(3))) bf16x8*)(kp+512);
  kf[2]=*(const __attribute__((address_space(3))) bf16x8*)(kp+2048); kf[3]=*(const __attribute__((address_space(3))) bf16x8*)(kp+2560);
  kf[4]=*(const __attribute__((address_space(3))) bf16x8*)(kp+4096); kf[5]=*(const __attribute__((address_space(3))) bf16x8*)(kp+4608);
  kf[6]=*(const __attribute__((address_space(3))) bf16x8*)(kp+6144); kf[7]=*(const __attribute__((address_space(3))) bf16x8*)(kp+6656);
}
__device__ __forceinline__ void kload2(bf16x8*kf,lds_cptr kp,int j){ kf[2*j]=*(const __attribute__((address_space(3))) bf16x8*)(kp+j*2048); kf[2*j+1]=*(const __attribute__((address_space(3))) bf16x8*)(kp+j*2048+512); }
__device__ __forceinline__ s16x4 vtr(lds_cptr p){ return __builtin_bit_cast(s16x4,__builtin_amdgcn_ds_read_tr16_b64_v4i16((__attribute__((address_space(3))) v4i16_t*)p)); }
__device__ __forceinline__ float rowmax(const f32x16&p0,const f32x16&p1){
  float a=max3f(p0[0],p0[1],p1[0]),b=max3f(p0[2],p0[3],p1[1]);a=max3f(a,p1[2],p1[3]);
  #pragma unroll
  for(int r=4;r<16;r+=4){a=max3f(a,p0[r],p0[r+1]);b=max3f(b,p0[r+2],p0[r+3]);a=max3f(a,p1[r],p1[r+1]);b=max3f(b,p1[r+2],p1[r+3]);}
  const float m=max2f(a,b);
  auto rr=__builtin_amdgcn_permlane32_swap(__float_as_uint(m),__float_as_uint(m),false,false);
  return max2f(__uint_as_float(rr[0]),__uint_as_float(rr[1]));
}
__device__ __forceinline__ void pv(f32x16*o,int vb,bf16x8 pa0,bf16x8 pa1,bf16x8 pa2,bf16x8 pa3){
  #pragma unroll
  for(int d0=0;d0<2;++d0){s16x4 lo[4],hi[4];
    #pragma unroll
    for(int ks=0;ks<4;++ks){
      asm volatile("ds_read_b64_tr_b16 %0,%1 offset:%c2":"=&v"(lo[ks]):"v"(vb),"i"(d0*4096+ks*1024):"memory");
      asm volatile("ds_read_b64_tr_b16 %0,%1 offset:%c2":"=&v"(hi[ks]):"v"(vb),"i"(d0*4096+ks*1024+512):"memory");}
    asm volatile("s_waitcnt lgkmcnt(0)":::"memory");SBAR();
    #define PK(k) (bf16x8){lo[k][0],lo[k][1],lo[k][2],lo[k][3],hi[k][0],hi[k][1],hi[k][2],hi[k][3]}
    o[d0]=__builtin_amdgcn_mfma_f32_32x32x16_bf16(pa0,PK(0),o[d0],0,0,0);
    o[d0]=__builtin_amdgcn_mfma_f32_32x32x16_bf16(pa1,PK(1),o[d0],0,0,0);
    o[d0]=__builtin_amdgcn_mfma_f32_32x32x16_bf16(pa2,PK(2),o[d0],0,0,0);
    o[d0]=__builtin_amdgcn_mfma_f32_32x32x16_bf16(pa3,PK(3),o[d0],0,0,0);
    #undef PK
  }
}

#ifndef ATTN_STORE16
#define ATTN_STORE16(p,v) (*(u32x4*)(p)=(v))
#endif
template<int THRL> __device__ __forceinline__ void attn_unit(int b,int h,int qb,const bf16*Q,const bf16*__restrict__ K,const bf16*__restrict__ V,bf16*O,const float*__restrict__ CSl,const float*__restrict__ TOTl,char*shm,const int tid_in){
  int tidu_=tid_in; asm volatile("":"+v"(tidu_)); const int tid=tidu_;
  const int lane=tid&63,r32=lane&31,hi=lane>>5; const int wid=__builtin_amdgcn_readfirstlane(tid>>6);
  const long rowbase=(long)b*SEQ; const int q0=qb*QB;
  const bf16*Qw=Q+(rowbase+q0+wid*QBLK)*DM+h*D;
  const bf16*Kh=K+rowbase*DM+h*D,*Vh=V+rowbase*DM+h*D;
  const unsigned lds0=(unsigned)(uintptr_t)shm;
  float*wsf=(float*)(shm+LDS_WS)+wid*64;
  {
    typedef __attribute__((address_space(3))) f32x4_t lf4;
    const int bh_=b*NHEAD+h; int tidl_=tid; asm volatile("":"+v"(tidl_));
    const f32x4_t*c4=(const f32x4_t*)(CSl+(long)bh_*SEQ); lf4*bl=(lf4*)((__attribute__((address_space(3))) char*)shm+LDS_BIAS);
    const int n4=(q0+QB)/4;
    { f32x4_t cq_[4];
      #pragma unroll
      for(int j_=0;j_<4;++j_){ const int i4=tidl_+j_*NW*64; cq_[j_]=(i4<n4)?c4[i4]:f32x4_t{0.f,0.f,0.f,0.f}; }
      #pragma unroll
      for(int j_=0;j_<4;++j_){ const int i4=tidl_+j_*NW*64; if(i4<n4)bl[i4]=cq_[j_]; } }
    asm volatile("s_waitcnt lgkmcnt(0)":::"memory");
  }
  const bf16*ksrc=Kh+(long)lane*DM+wid*8;
  const bf16*vsrc=Vh+(long)(16*(wid&3)+(lane>>2))*DM+(wid>>2)*32+(lane&3)*8;
  const unsigned kdst=lds0+LDS_K+wid*1024, vdst=lds0+LDS_V+wid*1024;
  #define DMA_K(t,slot) glds16(ksrc+(long)(t)*KVBLK*DM,(unsigned)__builtin_amdgcn_readfirstlane(kdst+(slot)))
  #define DMA_V(t,slot) glds16(vsrc+(long)(t)*KVBLK*DM,(unsigned)__builtin_amdgcn_readfirstlane(vdst+(slot)))
  const int vb0=(int)(lds0+LDS_V)+((lane>>4)&1)*32+(lane&3)*8+(4*hi+((lane&15)>>2))*64;
  const char*Kbase=shm+LDS_K; bf16x8 kf[8];
  const lds_cptr shm3=(lds_cptr)shm; const lds_cptr kp0=shm3+LDS_K+hi*1024+r32*16; const lds_cptr vp0=shm3+LDS_V+((lane>>4)&1)*32+(lane&3)*8+(4*hi+((lane&15)>>2))*64;
  const int NT=(q0+QB)/KVBLK;
  DMA_K(0,0);DMA_V(0,0);DMA_K(1,SLOTB);
  bf16x8 qr[4];
  #pragma unroll
  for(int d0=0;d0<4;++d0)qr[d0]=*reinterpret_cast<const bf16x8*>(&Qw[(long)r32*DM+d0*16+hi*8]);
  float mhat=0.f,l_reg=0.f;f32x16 o[2];o[0]=f32x16{};o[1]=f32x16{};
  const unsigned hmsk_=hi?0u:0xFFFFFFFFu;
  u32x4 qb_, abA0, abA1; asm volatile("":"=v"(qb_),"=v"(abA0),"=v"(abA1));
  #define MHSPLIT() do{ const unsigned mb_=__float_as_uint(mhat); const float r1_=mhat-__uint_as_float(mb_&0xFFFF0000u); const unsigned rb_=__float_as_uint(r1_); const float r2_=r1_-__uint_as_float(rb_&0xFFFF0000u); \
    qb_.x=0x3F803F80u&hmsk_; qb_.y=(0x3F80u|(mb_&0xFFFF0000u))&hmsk_; qb_.z=((rb_>>16)|(__float_as_uint(r2_)&0xFFFF0000u))&hmsk_; qb_.w=0u; asm volatile("":"+v"(qb_)); }while(0)
  #define BFRAG(AB,bv) do{ const unsigned bb_=__float_as_uint(bv); const float r1_=(bv)-__uint_as_float(bb_&0xFFFF0000u); const unsigned rb_=__float_as_uint(r1_); const float r2_=r1_-__uint_as_float(rb_&0xFFFF0000u); \
    AB.x=((bb_>>16)|(rb_&0xFFFF0000u))&hmsk_; AB.y=((__float_as_uint(r2_)>>16)|0xBF800000u)&hmsk_; AB.z=0xBF80BF80u&hmsk_; AB.w=0u; }while(0)
  #define LOADBF(AB0,AB1,tt) do{ const __attribute__((address_space(3))) float*bp_=(const __attribute__((address_space(3))) float*)(shm3+LDS_BIAS)+(tt)*64+r32; const float b0_=bp_[0],b1_=bp_[32]; BFRAG(AB0,b0_); BFRAG(AB1,b1_); asm volatile("":"+v"(AB0),"+v"(AB1)); }while(0)
  #define LOADBR(tt) do{ const __attribute__((address_space(3))) float*bp_=(const __attribute__((address_space(3))) float*)(shm3+LDS_BIAS)+(tt)*64+r32; braw0_=bp_[0]; braw1_=bp_[32]; }while(0)
  #define MAKEBF(AB0,AB1) do{ BFRAG(AB0,braw0_); BFRAG(AB1,braw1_); asm volatile("":"+v"(AB0),"+v"(AB1)); }while(0)
  #define BF8(x) __builtin_bit_cast(bf16x8,x)
  const int qrel=wid*QBLK+r32;
  #define CMASK(P0,P1,t) do{int jb_=(t)-(NT-4); if(jb_>=0)cmask(P0,P1,jb_,qrel,hi);}while(0)
  bool resc=false;
  #define START(P0,P1) do{ const float rm=rowmax(P0,P1); resc=false; \
    { const float dl=rm; mhat=fadd_s(mhat,dl); \
      _Pragma("unroll") for(int r=0;r<16;++r){P0[r]=fsub_s(P0[r],dl);P1[r]=fsub_s(P1[r],dl);} } \
    _Pragma("unroll") for(int r=0;r<16;++r)P0[r]=__builtin_amdgcn_exp2f(P0[r]); }while(0)
  #define RESC() do{ if(resc){ asm volatile("s_waitcnt lgkmcnt(0)":::"memory"); \
      _Pragma("unroll") for(int d_=0;d_<2;++d_) _Pragma("unroll") for(int r=0;r<16;++r)o[d_][r]*=wsf[crow(r,hi)]; } }while(0)
  f32x16 pA0,pA1,pB0,pB1;
  int sl_prev=0,sl_cur=0,sl_next=SLOTB;
  #define ROT() do{sl_prev=sl_cur;sl_cur=sl_next;sl_next=(sl_next==(NSLOT-1)*SLOTB)?0:sl_next+SLOTB;}while(0)
  DMA_K(2,2*SLOTB);
  WAIT_BAR(3);
  LOADBF(abA0,abA1,0); MHSPLIT(); qkt(pA0,pA1,Kbase,qr,r32,hi,BF8(abA0),BF8(abA1),BF8(qb_));asm volatile("s_nop 15\n\ts_nop 7":"+v"(pA0),"+v"(pA1));CMASK(pA0,pA1,0);
  START(pA0,pA1);
  _Pragma("unroll") for(int r=0;r<16;++r)pA1[r]=__builtin_amdgcn_exp2f(pA1[r]);
  MHSPLIT(); LOADBF(abA0,abA1,1);
  WAIT_BAR(0);
  DMA_K(3,0);DMA_V(1,SLOTB);
  ROT();
  kload8(kf,kp0+sl_cur);
  WAIT_BAR(2);
  s16x4 vlo[8],vhi[8]; u32x4 pw0,pw1,pw2,pw3; asm volatile("":"=v"(pw0),"=v"(pw1),"=v"(pw2),"=v"(pw3));
  #define PKW(P,B) cvtpk_s(P[B],P[B+1])
  #define PAF(k) __builtin_bit_cast(bf16x8,pw##k)
  #define VFR(i) (bf16x8){vlo[i][0],vlo[i][1],vlo[i][2],vlo[i][3],vhi[i][0],vhi[i][1],vhi[i][2],vhi[i][3]}
  #define PIN(x) asm volatile("":"+v"(x))
  #define MX3(a,b,c) __builtin_fmaxf(__builtin_fmaxf((a),(b)),(c))
  #define GAPA(MF,A0,A1,A2,A3,W0,W1,PW) do{ MF; sacc+=A0; sacc+=A1; sacc+=A2; sacc+=A3; PIN(sacc); W0; W1; PIN(PW); SBAR(); }while(0)
  #define EX(v) __builtin_amdgcn_exp2f(v)
  #define GAPB(MF,X,B) do{ MF; X[B]=EX(X[B]); X[B+1]=EX(X[B+1]); X[B+2]=EX(X[B+2]); X[B+3]=EX(X[B+3]); PIN(X); SBAR(); }while(0)
  #define VRD(i) do{ vlo[i]=vtr(vp_+(((i)>>2)*4096+((i)&3)*1024)); vhi[i]=vtr(vp_+(((i)>>2)*4096+((i)&3)*1024+512)); }while(0)
  #define KRD(G,j) do{ if(G){ kload2(kf,kp0+sl_next,j); SBAR(); } }while(0)
  #define STEP(C0,C1,P0,P1,t,GK,GV,GL,AB0,AB1,NB0,NB1) do{ SBAR(); \
    C0=__builtin_amdgcn_mfma_f32_32x32x16_bf16(BF8(AB0),BF8(qb_),f32x16{},0,0,0); C1=__builtin_amdgcn_mfma_f32_32x32x16_bf16(BF8(AB1),BF8(qb_),f32x16{},0,0,0); SBAR(); \
    const lds_cptr vp_=vp0+sl_prev; \
    VRD(0); SBAR(); float sacc=(P0[0]+P0[1]); \
    GAPA(C0=__builtin_amdgcn_mfma_f32_32x32x16_bf16(kf[0],qr[0],C0,0,0,0), P0[2],P0[3],P0[4],P0[5],     pw0[0]=PKW(P0,0), pw0[1]=PKW(P0,2), pw0); \
    VRD(4); SBAR(); GAPA(C1=__builtin_amdgcn_mfma_f32_32x32x16_bf16(kf[1],qr[0],C1,0,0,0), P0[6],P0[7],P0[8],P0[9],     pw0[2]=PKW(P0,4), pw0[3]=PKW(P0,6), pw0); \
    VRD(1); SBAR(); GAPA(C0=__builtin_amdgcn_mfma_f32_32x32x16_bf16(kf[2],qr[1],C0,0,0,0),   P0[10],P0[11],P0[12],P0[13], pw1[0]=PKW(P0,8), pw1[1]=PKW(P0,10), pw1); \
    VRD(5); SBAR(); GAPA(C1=__builtin_amdgcn_mfma_f32_32x32x16_bf16(kf[3],qr[1],C1,0,0,0),   P0[14],P0[15],P1[0],P1[1],   pw1[2]=PKW(P0,12),pw1[3]=PKW(P0,14), pw1); \
    VRD(2); SBAR(); GAPA(C0=__builtin_amdgcn_mfma_f32_32x32x16_bf16(kf[4],qr[2],C0,0,0,0),   P1[2],P1[3],P1[4],P1[5],     pw2[0]=PKW(P1,0), pw2[1]=PKW(P1,2), pw2); \
    VRD(6); SBAR(); GAPA(C1=__builtin_amdgcn_mfma_f32_32x32x16_bf16(kf[5],qr[2],C1,0,0,0),   P1[6],P1[7],P1[8],P1[9],     pw2[2]=PKW(P1,4), pw2[3]=PKW(P1,6), pw2); \
    VRD(3); SBAR(); GAPA(C0=__builtin_amdgcn_mfma_f32_32x32x16_bf16(kf[6],qr[3],C0,0,0,0),   P1[10],P1[11],P1[12],P1[13], pw3[0]=PKW(P1,8), pw3[1]=PKW(P1,10), pw3); \
    VRD(7); SBAR(); GAPA(C1=__builtin_amdgcn_mfma_f32_32x32x16_bf16(kf[7],qr[3],C1,0,0,0),   P1[14],P1[15],0.f,0.f,       pw3[2]=PKW(P1,12),pw3[3]=PKW(P1,14), pw3); \
    l_reg+=sacc; \
    if(GK){DMA_K((t)+3,sl_cur);} if(GV){DMA_V((t)+1,sl_next);} \
    CMASK(C0,C1,t); \
    { float a=MX3(C0[0],C0[1],C1[0]),b=MX3(C0[2],C0[3],C1[1]); a=MX3(a,C1[2],C1[3]); \
      _Pragma("unroll") for(int r=4;r<16;r+=4){a=MX3(a,C0[r],C0[r+1]);b=MX3(b,C0[r+2],C0[r+3]);a=MX3(a,C1[r],C1[r+1]);b=MX3(b,C1[r+2],C1[r+3]);} \
      float rm=__builtin_fmaxf(a,b); { auto rr=__builtin_amdgcn_permlane32_swap(__float_as_uint(rm),__float_as_uint(rm),false,false); rm=__builtin_fmaxf(__uint_as_float(rr[0]),__uint_as_float(rr[1])); } \
      resc=false; \
      if(__builtin_expect(__any(rm>(float)THRL),0)){ const float dl=__builtin_fmaxf(rm,0.f); mhat+=dl; \
        _Pragma("unroll") for(int r=0;r<16;++r){C0[r]-=dl;C1[r]-=dl;} MHSPLIT(); \
        const float f=__builtin_amdgcn_exp2f(-dl); l_reg*=f; if(hi==0)wsf[r32]=f; resc=true; } } \
    SBAR(); \
    float braw0_=0.f,braw1_=0.f; \
    GAPB(o[0]=__builtin_amdgcn_mfma_f32_32x32x16_bf16(PAF(0),VFR(0),o[0],0,0,0), C0,0); \
    if(GV){LOADBR((t)+1); SBAR();} \
    GAPB(o[1]=__builtin_amdgcn_mfma_f32_32x32x16_bf16(PAF(0),VFR(4),o[1],0,0,0), C0,4); \
    if(GV){MAKEBF(NB0,NB1); SBAR();} \
    KRD(GL,0); GAPB(o[0]=__builtin_amdgcn_mfma_f32_32x32x16_bf16(PAF(1),VFR(1),o[0],0,0,0), C0,8); \
    KRD(GL,1); GAPB(o[1]=__builtin_amdgcn_mfma_f32_32x32x16_bf16(PAF(1),VFR(5),o[1],0,0,0), C0,12); \
    KRD(GL,2); GAPB(o[0]=__builtin_amdgcn_mfma_f32_32x32x16_bf16(PAF(2),VFR(2),o[0],0,0,0), C1,0); \
    KRD(GL,3); GAPB(o[1]=__builtin_amdgcn_mfma_f32_32x32x16_bf16(PAF(2),VFR(6),o[1],0,0,0), C1,4); \
    GAPB(o[0]=__builtin_amdgcn_mfma_f32_32x32x16_bf16(PAF(3),VFR(3),o[0],0,0,0), C1,8); \
    GAPB(o[1]=__builtin_amdgcn_mfma_f32_32x32x16_bf16(PAF(3),VFR(7),o[1],0,0,0), C1,12); \
    }while(0)
  int t=1;
  #undef CMASK
  #define CMASK(P0,P1,t) do{}while(0)
  for(;t+5<NT;t+=2){
    STEP(pB0,pB1,pA0,pA1,t,true,true,true,abA0,abA1,abA0,abA1);     WAIT_BAR(2); RESC(); ROT();
    STEP(pA0,pA1,pB0,pB1,t+1,true,true,true,abA0,abA1,abA0,abA1);   WAIT_BAR(2); RESC(); ROT();
  }
  #undef CMASK
  #define CMASK(P0,P1,t) do{int jb_=(t)-(NT-4); if(jb_>=0)cmask(P0,P1,jb_,qrel,hi);}while(0)
  #define ENDW(tt) do{ if((tt)+3<NT){WAIT_BAR(2);} else if((tt)+2<NT){WAIT_BAR(1);} else {WAIT_BAR(0);} }while(0)
  for(;t+1<NT;t+=2){
    STEP(pB0,pB1,pA0,pA1,t,(t+3<NT),(t+1<NT),(t+1<NT),abA0,abA1,abA0,abA1);       ENDW(t);   RESC(); ROT();
    STEP(pA0,pA1,pB0,pB1,t+1,(t+4<NT),(t+2<NT),(t+2<NT),abA0,abA1,abA0,abA1);     ENDW(t+1); RESC(); ROT();
  }
  STEP(pB0,pB1,pA0,pA1,NT-1,false,false,false,abA0,abA1,abA0,abA1); RESC();
  { float sacc=pB0[0]+pB0[1]; _Pragma("unroll") for(int r=2;r<16;++r)sacc+=pB0[r]; _Pragma("unroll") for(int r=0;r<16;++r)sacc+=pB1[r]; l_reg+=sacc;
    pw0=(u32x4){PKW(pB0,0),PKW(pB0,2),PKW(pB0,4),PKW(pB0,6)};pw1=(u32x4){PKW(pB0,8),PKW(pB0,10),PKW(pB0,12),PKW(pB0,14)};pw2=(u32x4){PKW(pB1,0),PKW(pB1,2),PKW(pB1,4),PKW(pB1,6)};pw3=(u32x4){PKW(pB1,8),PKW(pB1,10),PKW(pB1,12),PKW(pB1,14)};
    SBAR(); pv(o,vb0+sl_cur,PAF(0),PAF(1),PAF(2),PAF(3)); }
  #undef PKW
  #undef PAF
  #undef VFR
  #undef PIN
  #undef MX3
  #undef GAPA
  #undef GAPB
  #undef EX
  #undef VRD
  #undef KRD
  #undef STEP
  #undef ENDW
  {auto rr=__builtin_amdgcn_permlane32_swap(__float_as_uint(l_reg),__float_as_uint(l_reg),false,false);l_reg=__uint_as_float(rr[0])+__uint_as_float(rr[1]);}
  if(hi==0)wsf[32+r32]=l_reg;asm volatile("s_waitcnt lgkmcnt(0)":::"memory");
  float rli[16];
  #pragma unroll
  for(int r=0;r<16;++r)rli[r]=__builtin_amdgcn_rcpf(wsf[32+crow(r,hi)]);
  bf16*Ow=O+(rowbase+q0+wid*QBLK)*DM+h*D;
  { bf16*stg=(bf16*)(shm+LDS_OST)+wid*2048;
    #pragma unroll
    for(int r=0;r<16;++r){const int orow=crow(r,hi);
      #pragma unroll
      for(int d0=0;d0<2;++d0)stg[orow*64+d0*32+r32]=__float2bfloat16(o[d0][r]*rli[r]);}
    asm volatile("s_waitcnt lgkmcnt(0)":::"memory");
    #pragma unroll
    for(int i=0;i<4;++i){int lane_e=lane; asm volatile("":"+v"(lane_e)); const int row=i*8+(lane_e>>3),ch=lane_e&7; const u32x4 v=*(const u32x4*)(stg+row*64+ch*8); ATTN_STORE16(Ow+(long)row*DM+ch*8,v);} }
  asm volatile("s_waitcnt lgkmcnt(0)\n\ts_barrier":::"memory");
  #undef DMA_K
  #undef DMA_V
  #undef CMASK
  #undef START
  #undef RESC
  #undef ROT
  #undef LOADBF
  #undef LOADBR
  #undef MAKEBF
  #undef BFRAG
  #undef MHSPLIT
  #undef BF8
}
constexpr int ATTN_LDS_BYTES=LDS_BYTES;
struct AttnTensors { const bf16* Q; const bf16* K; const bf16* V; bf16* O; const float* CS; const float* TOT; };
struct AttnUnit { int bh; int qb; };
struct StaticOrder {
  int vcu, grid_;
  __device__ __forceinline__ explicit StaticOrder(int grid,int block):vcu((grid%8==0)?(block%8)*(grid/8)+block/8:block),grid_(grid){}
  __device__ __forceinline__ bool next(int i,AttnUnit&u)const{ if(grid_!=256){ const int un=i*grid_+vcu; if(un>=BATCH*NHEAD*NQB)return false; u.bh=un/NQB; u.qb=NQB-1-(un%NQB); return true; }
    if(i>=8)return false; const int s=vcu&7, ii=i&3; u.bh=(vcu>>3)+32*(i>>2); u.qb=(ii==0)?31-s:(ii==1)?16+s:(ii==2)?15-s:s; return true; }
  __device__ __forceinline__ void a_ready(const AttnUnit&)const{}
  __device__ __forceinline__ void done(const AttnUnit&)const{}
};
template<class Sched,int THRL=64> __device__ __forceinline__ void attn_phase(char*lds,const AttnTensors&T,const Sched&S,const int tid){
  AttnUnit u;
  for(int i=0;S.next(i,u);++i){ S.a_ready(u); attn_unit<THRL>(u.bh/NHEAD,u.bh%NHEAD,u.qb,T.Q,T.K,T.V,T.O,T.CS,T.TOT,lds,tid); S.done(u); }
}
#undef SBAR
#undef WAIT_BAR
}
namespace cg = cooperative_groups;
#define LAS __attribute__((address_space(3)))
#define GASM __attribute__((address_space(1)))
typedef unsigned short bf16;
typedef unsigned v4u __attribute__((ext_vector_type(4)));
typedef unsigned v2u __attribute__((ext_vector_type(2)));
typedef float f32x4 __attribute__((ext_vector_type(4)));
typedef float f32x2 __attribute__((ext_vector_type(2)));
typedef float f32x16 __attribute__((ext_vector_type(16)));
typedef short bf16x8 __attribute__((ext_vector_type(8)));
using pg8::O_YP; using pg8::O_PCA; using pg8::O_PFC; using pg8::O_SCA; using pg8::O_SFC;
static_assert(attn_body::LDS_BYTES <= 131072, "attention LDS");
struct Args { const float* in[22]; float* out; unsigned char* ws; };
enum { I_XP = 0, I_XS, I_SCA, I_SFC, I_CK, I_CV, I_CLF, I_ANORM, I_WAIN, I_ACW, I_WAOUT, I_KVNORM, I_WKV, I_BF, I_BNORM, I_WQ, I_WO, I_FNORM, I_WUP, I_FCW, I_WDN, I_FINAL };

__device__ __forceinline__ unsigned f2bf(float f) { unsigned u = __builtin_bit_cast(unsigned, f); return (u + 0x7fffu + ((u >> 16) & 1u)) >> 16; }
__device__ __forceinline__ unsigned pk2(float lo, float hi) { return pg8::cvt_pk_bf16(lo, hi); }
__device__ __forceinline__ float bflo(unsigned w) { return __uint_as_float(w << 16); }
__device__ __forceinline__ float bfhi(unsigned w) { return __uint_as_float(w & 0xffff0000u); }
#define LDS_WAIT() asm volatile("s_waitcnt lgkmcnt(0)" ::: "memory")
__device__ __forceinline__ float wave_sum(float v) {
#pragma unroll
    for (int o = 1; o < 64; o <<= 1) v += __shfl_xor(v, o);
    return v;
}
__device__ __forceinline__ void transpose_item(const float* W, int K, int N, const float* gain, bf16* WT, LAS float* scr, int kb, int srcn0, int valid, int dstn0, int lane) {
    const int k0 = 64 * kb, c = lane & 31;
    float wv[32];
#pragma unroll
    for (int i = 0; i < 32; ++i) { const int kk = 2 * i + (lane >> 5); wv[i] = (c < valid) ? __builtin_nontemporal_load(W + (size_t)(k0 + kk) * N + srcn0 + c) : 0.f; }
    if (gain) {
#pragma unroll
        for (int i = 0; i < 32; ++i) wv[i] *= gain[k0 + 2 * i + (lane >> 5)];
    }
#pragma unroll
    for (int i = 0; i < 32; ++i) scr[(2 * i + (lane >> 5)) * 33 + c] = wv[i];
    LDS_WAIT(); asm volatile("" ::: "memory");
    const int c8 = lane & 7;
#pragma unroll
    for (int j = 0; j < 4; ++j) { const int n = (lane >> 3) + 8 * j; const LAS float* s = scr + (8 * c8) * 33 + n;
        v4u o; o.x = pk2(s[0 * 33], s[1 * 33]); o.y = pk2(s[2 * 33], s[3 * 33]); o.z = pk2(s[4 * 33], s[5 * 33]); o.w = pk2(s[6 * 33], s[7 * 33]);
        *(v4u*)(WT + (size_t)(dstn0 + n) * K + k0 + 8 * c8) = o; }
    LDS_WAIT(); asm volatile("" ::: "memory");
}

__device__ __forceinline__ void p0_prologue(const Args& a, LAS unsigned char* lds, int vcu, int G, int wave, int lane) {
    LAS float* scr = (LAS float*)(lds + wave * 16384);
    const int gw = vcu * NWAVES + wave, NGW = G * NWAVES;
    unsigned char* ws = a.ws;
    constexpr int I0 = 16 * 96, I1 = 16 * 32, I2 = 16 * 176, I4 = 44 * 32, I6 = 16 * 104, I7 = 16 * 32;
    constexpr int NITEMS = I0 + I1 + 2 * I2 + 2 * I4 + I6 + I7;
    for (int it = gw; it < NITEMS; it += NGW) {
        int r = it;
        if (r < I0) { const int kb = r / 96, np = 32 * (r % 96), tile = np >> 8, bj = (np & 255) >> 7, j = np & 127;
            const int src = tile < 8 ? 1024 + 1024 * bj + 128 * tile + j : np - 2048;
            transpose_item(a.in[I_WAIN], 1024, 3072, a.in[I_ANORM], (bf16*)(ws + WS_WAIN), scr, kb, src, 32, np, lane); continue; } r -= I0;
        if (r < I1) { transpose_item(a.in[I_WAOUT], 1024, 1024, nullptr, (bf16*)(ws + WS_WAOUT), scr, r / 32, 32 * (r % 32), 32, 32 * (r % 32), lane); continue; } r -= I1;
        if (r < 2 * I2) { const int l = r / I2; r -= l * I2; const int kb = r / 176, np = 32 * (r % 176), tile = np >> 8, bj = (np & 255) >> 7, j = np & 127;
            transpose_item(a.in[I_WUP] + (size_t)l * 1024 * FF2, 1024, FF2, a.in[I_FNORM] + l * 1024, (bf16*)(ws + WS_WUP) + (size_t)l * FF2 * 1024, scr, kb, bj * FF + 128 * tile + j, 32, np, lane); continue; } r -= 2 * I2;
        if (r < 2 * I4) { const int l = r / I4; r -= l * I4;
            transpose_item(a.in[I_WDN] + (size_t)l * FF * 1024, FF, 1024, nullptr, (bf16*)(ws + WS_WDN) + (size_t)l * 1024 * FF, scr, r / 32, 32 * (r % 32), 32, 32 * (r % 32), lane); continue; } r -= 2 * I4;
        if (r < I6) { const int kb = r / 104, np = 32 * (r % 104);
            if (np < 2048) transpose_item(a.in[I_WKV], 1024, 2064, a.in[I_KVNORM], (bf16*)(ws + WS_WKVQ), scr, kb, np, 32, np, lane);
            else if (np < 3072) transpose_item(a.in[I_WQ], 1024, 1024, a.in[I_BNORM], (bf16*)(ws + WS_WKVQ), scr, kb, np - 2048, 32, np, lane);
            else transpose_item(a.in[I_WKV], 1024, 2064, a.in[I_KVNORM], (bf16*)(ws + WS_WKVQ), scr, kb, 2048, np == 3072 ? 16 : 0, np, lane);
            continue; } r -= I6;
        transpose_item(a.in[I_WO], 1024, 1024, nullptr, (bf16*)(ws + WS_WO), scr, r / 32, 32 * (r % 32), 32, 32 * (r % 32), lane);
    }
    bf16* X = (bf16*)(ws + WS_X); float* ssq0 = (float*)(ws + WS_SSQ0);
    for (int m0 = gw; m0 < M; m0 += 2 * NGW) {
        const int m1 = m0 + NGW; const bool has1 = m1 < M;
        const float* xrow0 = m0 < MP ? a.in[I_XP] + (size_t)m0 * DM : a.in[I_XS] + (size_t)(m0 - MP) * DM;
        const float* xrow1 = !has1 ? xrow0 : (m1 < MP ? a.in[I_XP] + (size_t)m1 * DM : a.in[I_XS] + (size_t)(m1 - MP) * DM);
        const f32x4* xr0 = (const f32x4*)xrow0 + lane; const f32x4* xr1 = (const f32x4*)xrow1 + lane;
        f32x4 v0[4], v1[4]; float s0 = 0.f, s1 = 0.f;
#pragma unroll
        for (int j = 0; j < 4; ++j) { v0[j] = __builtin_nontemporal_load(xr0 + 64 * j); v1[j] = __builtin_nontemporal_load(xr1 + 64 * j); }
#pragma unroll
        for (int j = 0; j < 4; ++j) { s0 += (v0[j].x * v0[j].x + v0[j].y * v0[j].y) + (v0[j].z * v0[j].z + v0[j].w * v0[j].w); s1 += (v1[j].x * v1[j].x + v1[j].y * v1[j].y) + (v1[j].z * v1[j].z + v1[j].w * v1[j].w); }
        s0 = wave_sum(s0); s1 = wave_sum(s1);
        v2u* o80 = (v2u*)(X + (size_t)m0 * DM) + lane;
#pragma unroll
        for (int j = 0; j < 4; ++j) { v2u w; w.x = pk2(v0[j].x, v0[j].y); w.y = pk2(v0[j].z, v0[j].w); o80[64 * j] = w; }
        if (lane < SSQ_SLOTS) ssq0[(size_t)m0 * SSQ_SLOTS + lane] = lane == 0 ? s0 : 0.f;
        if (has1) {
            v2u* o81 = (v2u*)(X + (size_t)m1 * DM) + lane;
#pragma unroll
            for (int j = 0; j < 4; ++j) { v2u w; w.x = pk2(v1[j].x, v1[j].y); w.y = pk2(v1[j].z, v1[j].w); o81[64 * j] = w; }
            if (lane < SSQ_SLOTS) ssq0[(size_t)m1 * SSQ_SLOTS + lane] = lane == 0 ? s1 : 0.f;
        }
    }
}

__device__ __forceinline__ void p2_mixer(const Args& a, int vcu, int G, int tid) {
    const bf16* CU = (const bf16*)(a.ws + WS_CU); const bf16* GB = (const bf16*)(a.ws + WS_GB); bf16* MB = (bf16*)(a.ws + WS_MB);
    const float* cw = a.in[I_ACW];
    const long nth = (long)G * 512;
    for (long idx = (long)vcu * 512 + tid; idx < (long)(M / 4) * 128; idx += nth) {
        const int r0 = M - 4 - 4 * (int)(idx >> 7), c8 = (int)(idx & 127) * 8;
        int t0, b, T; const bool smp = r0 >= MP;
        if (!smp) { t0 = r0 & (TP - 1); b = r0 >> 13; T = TP; } else { t0 = (r0 - MP) & 31; b = (r0 - MP) >> 5; T = 32; }
        v4u xr[6], gr[4];
#pragma unroll
        for (int i = 0; i < 4; ++i) { xr[2 + i] = *(const v4u*)(CU + (size_t)(r0 + i) * DM + c8); gr[i] = __builtin_nontemporal_load((const v4u*)(GB + (size_t)(r0 + i) * DM + c8)); }
        float w[6][8];
        if (t0 != 0) { xr[0] = *(const v4u*)(CU + (size_t)(r0 - 2) * DM + c8); xr[1] = *(const v4u*)(CU + (size_t)(r0 - 1) * DM + c8); }
        else { xr[0] = (v4u){0u, 0u, 0u, 0u}; xr[1] = xr[0]; }
#pragma unroll
        for (int i = 0; i < 6; ++i) { w[i][0] = bflo(xr[i].x); w[i][1] = bfhi(xr[i].x); w[i][2] = bflo(xr[i].y); w[i][3] = bfhi(xr[i].y); w[i][4] = bflo(xr[i].z); w[i][5] = bfhi(xr[i].z); w[i][6] = bflo(xr[i].w); w[i][7] = bfhi(xr[i].w); }
        if (t0 == 0 && smp) { const float* st = a.in[I_SCA] + (size_t)b * 2 * DM + c8;
#pragma unroll
            for (int e = 0; e < 8; ++e) { w[0][e] = st[e]; w[1][e] = st[DM + e]; } }
        float c0[8], c1[8], c2[8];
#pragma unroll
        for (int e = 0; e < 8; ++e) { c0[e] = cw[c8 + e]; c1[e] = cw[DM + c8 + e]; c2[e] = cw[2 * DM + c8 + e]; }
#pragma unroll
        for (int i = 0; i < 4; ++i) {
            const v4u gx = gr[i];
            float g[8]; g[0] = bflo(gx.x); g[1] = bfhi(gx.x); g[2] = bflo(gx.y); g[3] = bfhi(gx.y); g[4] = bflo(gx.z); g[5] = bfhi(gx.z); g[6] = bflo(gx.w); g[7] = bfhi(gx.w);
            float o[8];
#pragma unroll
            for (int e = 0; e < 8; ++e) o[e] = g[e] * (c0[e] * w[i][e] + c1[e] * w[i + 1][e] + c2[e] * w[i + 2][e]);
            v4u ww; ww.x = pk2(o[0], o[1]); ww.y = pk2(o[2], o[3]); ww.z = pk2(o[4], o[5]); ww.w = pk2(o[6], o[7]);
            *(v4u*)(MB + (size_t)(r0 + i) * DM + c8) = ww;
        }
        if (t0 == T - 4) {
#pragma unroll
            for (int j = 0; j < 2; ++j) { float* d = a.out + (smp ? O_SCA : O_PCA) + ((size_t)b * 2 + j) * DM + c8;
#pragma unroll
                for (int e = 0; e < 8; ++e) d[e] = w[4 + j][e]; }
        }
    }
}

__device__ __forceinline__ float silu_f(float x) { return x * __builtin_amdgcn_rcpf(1.0f + __builtin_amdgcn_exp2f(-x * LOG2E)); }
__device__ __forceinline__ void p5_ffn_elem(const Args& a, int l, int vcu, int G, int wave, int lane, const bool nostore) {
    bf16* UP = (bf16*)(a.ws + WS_UP); const bf16* HALO = (const bf16*)(a.ws + WS_HALO);
    const int gw = vcu * NWAVES + wave, NGW = G * NWAVES;
    const float* cw = a.in[I_FCW] + (size_t)l * 3 * FF2;
    const float* ssq = (const float*)(a.ws + WS_SSQ0 + (size_t)(l ? 3 : 1) * SSQ_BYTES);
    for (int it = gw; it < 264 * 22; it += NGW) {
        const int blk = 263 - it / 22, pn = it % 22, row0 = blk * 128;
        const int colm = 256 * pn + 2 * lane, cg_ = 128 * pn + 2 * lane, cv_ = FF + cg_;
        const bool smp = row0 >= MP;
        f32x2 wg[3], wv[3];
#pragma unroll
        for (int i = 0; i < 3; ++i) { wg[i] = *(const f32x2*)(cw + i * FF2 + cg_); wv[i] = *(const f32x2*)(cw + i * FF2 + cv_); }
        f32x2 g1 = {0.f, 0.f}, g2 = {0.f, 0.f}, v1 = {0.f, 0.f}, v2 = {0.f, 0.f};
        const bool has_halo = !smp && (row0 & (TP - 1)) != 0;
        float rsA, rsB, rsH = 0.f;
        { const float* sa = ssq + (size_t)(row0 + lane) * SSQ_SLOTS; const float* sb = sa + (size_t)64 * SSQ_SLOTS; const float* sh = ssq + (size_t)(row0 - 2 + (lane & 1)) * SSQ_SLOTS;
          float ta = 0.f, tb = 0.f, th = 0.f;
#pragma unroll
          for (int j = 0; j < SSQ_SLOTS / 4; ++j) { const f32x4 x = *(const f32x4*)(sa + 4 * j), y = *(const f32x4*)(sb + 4 * j); ta += (x.x + x.y) + (x.z + x.w); tb += (y.x + y.y) + (y.z + y.w); }
          if (has_halo) {
#pragma unroll
              for (int j = 0; j < SSQ_SLOTS / 4; ++j) { const f32x4 z = *(const f32x4*)(sh + 4 * j); th += (z.x + z.y) + (z.z + z.w); }
              rsH = __builtin_amdgcn_rsqf(th * (1.0f / 1024.0f) + pg8::RMS_EPS);
          }
          rsA = __builtin_amdgcn_rsqf(ta * (1.0f / 1024.0f) + pg8::RMS_EPS); rsB = __builtin_amdgcn_rsqf(tb * (1.0f / 1024.0f) + pg8::RMS_EPS); }
        if (has_halo) {
            const unsigned hg2 = *(const unsigned*)(HALO + (size_t)((blk - 1) * 2 + 0) * FF2 + colm), hv2 = *(const unsigned*)(HALO + (size_t)((blk - 1) * 2 + 0) * FF2 + colm + 128);
            const unsigned hg1 = *(const unsigned*)(HALO + (size_t)((blk - 1) * 2 + 1) * FF2 + colm), hv1 = *(const unsigned*)(HALO + (size_t)((blk - 1) * 2 + 1) * FF2 + colm + 128);
            const float r2 = __shfl(rsH, 0), r1 = __shfl(rsH, 1);
            g2 = (f32x2){bflo(hg2), bfhi(hg2)} * r2; v2 = (f32x2){bflo(hv2), bfhi(hv2)} * r2; g1 = (f32x2){bflo(hg1), bfhi(hg1)} * r1; v1 = (f32x2){bflo(hv1), bfhi(hv1)} * r1;
        }
        for (int rb = 0; rb < 128; rb += 16) {
            unsigned gr[16], vr[16], orr[16];
#pragma unroll
            for (int i = 0; i < 16; ++i) { const bf16* p = UP + (size_t)(row0 + rb + i) * FF2 + colm; gr[i] = __builtin_nontemporal_load((const unsigned*)p); vr[i] = __builtin_nontemporal_load((const unsigned*)(p + 128)); }
            if (smp && (rb & 31) == 0) {
                const int b = (row0 + rb - MP) >> 5; const float* st = a.in[I_SFC] + ((size_t)(l * 32 + b) * 2) * FF2;
                g2 = *(const f32x2*)(st + cg_); v2 = *(const f32x2*)(st + cv_); g1 = *(const f32x2*)(st + FF2 + cg_); v1 = *(const f32x2*)(st + FF2 + cv_);
            }
            const float rsSel = rb < 64 ? rsA : rsB;
#pragma unroll
            for (int i = 0; i < 16; ++i) {
                const float rsr = __shfl(rsSel, (rb & 63) + i);
                const f32x2 g0 = (f32x2){bflo(gr[i]), bfhi(gr[i])} * rsr, v0 = (f32x2){bflo(vr[i]), bfhi(vr[i])} * rsr;
                const f32x2 cg = wg[0] * g2 + wg[1] * g1 + wg[2] * g0, cv = wv[0] * v2 + wv[1] * v1 + wv[2] * v0;
                orr[i] = pk2(silu_f(cg.x) * cv.x, silu_f(cg.y) * cv.y);
                g2 = g1; g1 = g0; v2 = v1; v1 = v0;
                const int rr = rb + i;
                const bool last2 = smp ? ((rr & 31) >= 30) : (((blk & 63) == 63) && rr >= 126);
                if (last2) {
                    const int row = row0 + rr; const int j = smp ? (rr & 31) - 30 : rr - 126;
                    float* d = smp ? a.out + O_SFC + ((size_t)(l * 32 + ((row - MP) >> 5)) * 2 + j) * FF2 : a.out + O_PFC + ((size_t)(l * 4 + (row >> 13)) * 2 + j) * FF2;
                    *(f32x2*)(d + cg_) = g0; *(f32x2*)(d + cv_) = v0;
                }
            }
#pragma unroll
            for (int i = 0; i < 16; ++i) { if (!nostore) *(unsigned*)(UP + (size_t)(row0 + rb + i) * FF2 + colm) = orr[i]; else asm volatile("" :: "v"(orr[i])); }
        }
    }
}

__device__ __forceinline__ void p8_scan(const Args& a, int bh, LAS unsigned char* lds, int wave, int lane) {
    const float* LOGF = (const float*)(a.ws + WS_LOGF); float* BT = (float*)(a.ws + WS_CS);
    LAS float* tot = (LAS float*)lds;
    const int b = bh >> 4, h = bh & 15;
    float v[4][4];
#pragma unroll
    for (int c = 0; c < 4; ++c) {
        const size_t base = (size_t)b * TP + 256 * (4 * wave + c);
#pragma unroll
        for (int j = 0; j < 4; ++j) v[c][j] = LOGF[(base + 64 * j + lane) * 16 + h];
    }
#pragma unroll
    for (int c = 0; c < 4; ++c) {
        float off = 0.f;
#pragma unroll
        for (int j = 0; j < 4; ++j) {
            float s = v[c][j];
#pragma unroll
            for (int d = 1; d < 64; d <<= 1) { const float t = __shfl_up(s, d); if (lane >= d) s += t; }
            v[c][j] = s + off;
            off += __shfl(s, 63);
        }
        if (lane == 0) tot[4 * wave + c] = off;
    }
    __syncthreads();
    float pre = 0.f;
    for (int i = 0; i < 4 * wave; ++i) pre += tot[i];
#pragma unroll
    for (int c = 0; c < 4; ++c) {
#pragma unroll
        for (int j = 0; j < 4; ++j) BT[(size_t)bh * TP + 256 * (4 * wave + c) + 64 * j + lane] = -(v[c][j] + pre) * LOG2E;
        pre += tot[4 * wave + c];
    }
    __syncthreads();
}

__device__ __forceinline__ void sample_unit(const Args& a, int b, int h, LAS unsigned char* lds, int tid, int lane, int wid) {
    bf16* QB = (bf16*)(a.ws + WS_QB); const bf16* KB = (const bf16*)(a.ws + WS_KB); const bf16* VB = (const bf16*)(a.ws + WS_VB); const float* LOGF = (const float*)(a.ws + WS_LOGF);
    LAS float* cs = (LAS float*)lds;
    LAS float* mw = (LAS float*)(lds + 8192);
    LAS float* lw = mw + 256;
    LAS float* Ow = (LAS float*)(lds + 16384);
    const int r32 = lane & 31, hi = lane >> 5;
    const float* clf = a.in[I_CLF] + (size_t)b * 1024 * 16 + h;
    {
      const float c0_ = __builtin_nontemporal_load(clf + (size_t)tid * 16), c1_ = __builtin_nontemporal_load(clf + (size_t)(tid + 512) * 16);
      float c2_ = 0.f; if (tid < 32) c2_ = LOGF[(size_t)(MP + b * 32 + tid) * 16 + h];
      cs[tid] = c0_; cs[tid + 512] = c1_; if (tid < 64) cs[1024 + tid] = c2_; }
    __syncthreads();
    if (wid == 0) {
        float v[17]; float s = 0.f;
#pragma unroll
        for (int i = 0; i < 17; ++i) { s += cs[17 * lane + i]; v[i] = s; }
        float inc = s;
#pragma unroll
        for (int d = 1; d < 64; d <<= 1) { const float t = __shfl_up(inc, d); if (lane >= d) inc += t; }
        const float ex = inc - s;
#pragma unroll
        for (int i = 0; i < 17; ++i) cs[17 * lane + i] = v[i] + ex;
    }
    __syncthreads();
    const float cref = cs[1023];
    const size_t qrow = (size_t)(MP + b * 32 + r32) * DM + h * 64;
    bf16x8 qr[4];
#pragma unroll
    for (int d0 = 0; d0 < 4; ++d0) qr[d0] = *(const GASM bf16x8*)(QB + qrow + d0 * 16 + hi * 8);
    float m = -INFINITY, l = 0.f;
    f32x16 o[2]; o[0] = f32x16{}; o[1] = f32x16{};
    const int ntl = 4 + (wid == 0 ? 1 : 0);
#pragma unroll 1
    for (int s = 0; s < ntl; ++s) {
        const int j = s < 4 ? wid + 8 * s : 32;
        f32x16 p;
#pragma unroll
        for (int r = 0; r < 16; ++r) p[r] = (cref - cs[32 * j + attn_body::crow(r, hi)]) * LOG2E;
        float vv[2][2][8];
        if (s < 4) {
            const GASM float* kp = (const GASM float*)a.in[I_CK] + (((size_t)b * 1024 + 32 * j + r32) * 16 + h) * 64 + hi * 8;
            f32x4 kx[4], ky[4];
#pragma unroll
            for (int d0 = 0; d0 < 4; ++d0) { kx[d0] = __builtin_nontemporal_load((const GASM f32x4*)(kp + d0 * 16)); ky[d0] = __builtin_nontemporal_load((const GASM f32x4*)(kp + d0 * 16 + 4)); }
#pragma unroll
            for (int ks = 0; ks < 2; ++ks)
#pragma unroll
                for (int d0 = 0; d0 < 2; ++d0) { const GASM float* vp = (const GASM float*)a.in[I_CV] + (((size_t)b * 1024 + 32 * j + 16 * ks + 4 * hi) * 16 + h) * 64 + 32 * d0 + r32;
#pragma unroll
                    for (int i = 0; i < 8; ++i) vv[ks][d0][i] = __builtin_nontemporal_load(vp + (size_t)((i & 3) + 8 * (i >> 2)) * 1024); }
#pragma unroll
            for (int d0 = 0; d0 < 4; ++d0) {
                const f32x4 x = kx[d0], y = ky[d0];
                v4u w; w.x = pk2(x.x, x.y); w.y = pk2(x.z, x.w); w.z = pk2(y.x, y.y); w.w = pk2(y.z, y.w);
                p = __builtin_amdgcn_mfma_f32_32x32x16_bf16(__builtin_bit_cast(bf16x8, w), qr[d0], p, 0, 0, 0);
            }
        } else {
#pragma unroll
            for (int ks = 0; ks < 2; ++ks)
#pragma unroll
                for (int d0 = 0; d0 < 2; ++d0) { const GASM bf16* vp = (const GASM bf16*)VB + (size_t)(MP + b * 32 + 16 * ks + 4 * hi) * DM + h * 64 + 32 * d0 + r32;
#pragma unroll
                    for (int i = 0; i < 8; ++i) vv[ks][d0][i] = bflo((unsigned)vp[(size_t)((i & 3) + 8 * (i >> 2)) * DM]); }
#pragma unroll
            for (int d0 = 0; d0 < 4; ++d0) p = __builtin_amdgcn_mfma_f32_32x32x16_bf16(*(const GASM bf16x8*)(KB + qrow + d0 * 16 + hi * 8), qr[d0], p, 0, 0, 0);
#pragma unroll
            for (int r = 0; r < 16; ++r) if (attn_body::crow(r, hi) > r32) p[r] = -INFINITY;
        }
        float mt = p[0];
#pragma unroll
        for (int r = 1; r < 16; ++r) mt = fmaxf(mt, p[r]);
        mt = fmaxf(mt, __shfl_xor(mt, 32));
        const float mn = fmaxf(m, mt), alpha = __builtin_amdgcn_exp2f(m - mn);
        float lt = 0.f;
#pragma unroll
        for (int r = 0; r < 16; ++r) { p[r] = __builtin_amdgcn_exp2f(p[r] - mn); lt += p[r]; }
        lt += __shfl_xor(lt, 32);
        l = l * alpha + lt; m = mn;
#pragma unroll
        for (int r = 0; r < 16; ++r) { const float ar = __shfl(alpha, attn_body::crow(r, hi)); o[0][r] *= ar; o[1][r] *= ar; }
#pragma unroll
        for (int ks = 0; ks < 2; ++ks) {
            v4u pw; pw.x = pk2(p[8 * ks], p[8 * ks + 1]); pw.y = pk2(p[8 * ks + 2], p[8 * ks + 3]); pw.z = pk2(p[8 * ks + 4], p[8 * ks + 5]); pw.w = pk2(p[8 * ks + 6], p[8 * ks + 7]);
            const bf16x8 pa = __builtin_bit_cast(bf16x8, pw);
#pragma unroll
            for (int d0 = 0; d0 < 2; ++d0) {
                v4u vw; vw.x = pk2(vv[ks][d0][0], vv[ks][d0][1]); vw.y = pk2(vv[ks][d0][2], vv[ks][d0][3]); vw.z = pk2(vv[ks][d0][4], vv[ks][d0][5]); vw.w = pk2(vv[ks][d0][6], vv[ks][d0][7]);
                o[d0] = __builtin_amdgcn_mfma_f32_32x32x16_bf16(pa, __builtin_bit_cast(bf16x8, vw), o[d0], 0, 0, 0);
            }
        }
    }
    if (hi == 0) { mw[wid * 32 + r32] = m; lw[wid * 32 + r32] = l; }
#pragma unroll
    for (int r = 0; r < 16; ++r)
#pragma unroll
        for (int d0 = 0; d0 < 2; ++d0) Ow[(wid * 32 + attn_body::crow(r, hi)) * 64 + 32 * d0 + r32] = o[d0][r];
    __syncthreads();
    {
        const int q = tid >> 4, dg = (tid & 15) * 4;
        float Mx = mw[q];
#pragma unroll
        for (int w = 1; w < 8; ++w) Mx = fmaxf(Mx, mw[w * 32 + q]);
        float Ls = 0.f; f32x4 acc = {0.f, 0.f, 0.f, 0.f};
#pragma unroll
        for (int w = 0; w < 8; ++w) { const float sc = __builtin_amdgcn_exp2f(mw[w * 32 + q] - Mx); Ls += lw[w * 32 + q] * sc; acc += *(const LAS f32x4*)(Ow + (w * 32 + q) * 64 + dg) * sc; }
        const float inv = 1.0f / Ls;
        v2u w2; w2.x = pk2(acc.x * inv, acc.y * inv); w2.y = pk2(acc.z * inv, acc.w * inv);
        *(GASM v2u*)(QB + (size_t)(MP + b * 32 + q) * DM + h * 64 + dg) = w2;
    }
    __syncthreads();
}

__device__ __forceinline__ void p14_final(const Args& a, int vcu, int G, int wave, int lane) {
    const bf16* X = (const bf16*)(a.ws + WS_X); const float* ssq = (const float*)(a.ws + WS_SSQ4);
    const int gw = vcu * NWAVES + wave, NGW = G * NWAVES;
    f32x4 gn[4];
#pragma unroll
    for (int j = 0; j < 4; ++j) gn[j] = *((const f32x4*)a.in[I_FINAL] + 64 * j + lane);
    for (int m0 = gw; m0 < M; m0 += 2 * NGW) {
        const int m1 = (m0 + NGW < M) ? m0 + NGW : m0; const bool has1 = m0 + NGW < M;
        float s0 = 0.f, s1 = 0.f;
#pragma unroll
        for (int j = 0; j < SSQ_SLOTS / 4; ++j) { const f32x4 p = *(const f32x4*)(ssq + (size_t)m0 * SSQ_SLOTS + 4 * j), q = *(const f32x4*)(ssq + (size_t)m1 * SSQ_SLOTS + 4 * j); s0 += (p.x + p.y) + (p.z + p.w); s1 += (q.x + q.y) + (q.z + q.w); }
        const v2u* xr0 = (const v2u*)(X + (size_t)m0 * DM) + lane; const v2u* xr1 = (const v2u*)(X + (size_t)m1 * DM) + lane;
        v2u w0[4], w1[4];
#pragma unroll
        for (int j = 0; j < 4; ++j) { w0[j] = xr0[64 * j]; w1[j] = xr1[64 * j]; }
        const float rs0 = __builtin_amdgcn_rsqf(s0 * (1.0f / 1024.0f) + pg8::RMS_EPS), rs1 = __builtin_amdgcn_rsqf(s1 * (1.0f / 1024.0f) + pg8::RMS_EPS);
        f32x4* o0 = (f32x4*)(a.out + O_YP + (size_t)m0 * DM) + lane; f32x4* o1 = (f32x4*)(a.out + O_YP + (size_t)m1 * DM) + lane;
#pragma unroll
        for (int j = 0; j < 4; ++j) { const f32x4 v = {bflo(w0[j].x), bfhi(w0[j].x), bflo(w0[j].y), bfhi(w0[j].y)}; __builtin_nontemporal_store(v * rs0 * gn[j], o0 + 64 * j); }
        if (has1) {
#pragma unroll
            for (int j = 0; j < 4; ++j) { const f32x4 v = {bflo(w1[j].x), bfhi(w1[j].x), bflo(w1[j].y), bfhi(w1[j].y)}; __builtin_nontemporal_store(v * rs1 * gn[j], o1 + 64 * j); }
        }
    }
}

#define RLX_AGENT __ATOMIC_RELAXED, __HIP_MEMORY_SCOPE_AGENT
#define XB_TMO      128
#define XB_XCNT(j)  (256  + 64 * (j))
#define XB_XSUB(j)  (1280 + 64 * (j))
#define XB_XGEN(j)  (2304 + 64 * (j))
#define XB_TOP      3328
#define XB_TOPGEN   3392
#define XCD_BAR_WORDS 3456
#define XB_SPIN_CAP (1u << 18)

__device__ __forceinline__ unsigned xb_ld(unsigned* p)              { return __hip_atomic_load(p, __ATOMIC_RELAXED, __HIP_MEMORY_SCOPE_AGENT); }
__device__ __forceinline__ unsigned xb_add(unsigned* p, unsigned v) { return __hip_atomic_fetch_add(p, v, __ATOMIC_RELAXED, __HIP_MEMORY_SCOPE_AGENT); }
__device__ __forceinline__ unsigned xb_xcc_id() { return (unsigned)__builtin_amdgcn_s_getreg((3 << 11) | 20) & 0xFu; }
#define XB_SPIN(cond, bar) do { unsigned _sp = 0; while (cond) { __builtin_amdgcn_s_sleep(1); \
    if ((++_sp & 255u) == 0u) { if (xb_ld(&(bar)[XB_TMO])) break; if (_sp > XB_SPIN_CAP) { atomicAdd(&(bar)[XB_TMO], 1u); break; } } } } while (0)

struct XcdBarrier {
    unsigned* bar; unsigned x;
    volatile LAS unsigned* st;
};

__device__ __forceinline__ XcdBarrier xcd_barrier_post(unsigned* bar, volatile LAS unsigned* st, bool leader) {
    XcdBarrier b; b.bar = bar; b.x = xb_xcc_id(); b.st = st;
    if (leader) (void)xb_add(&bar[XB_XCNT(b.x)], 1u);
    return b;
}
__device__ __forceinline__ void xcd_barrier_complete(unsigned* bar, unsigned x, unsigned& nloc, unsigned& nx) {
    const unsigned G = gridDim.x * gridDim.y * gridDim.z;
    unsigned sum, cnt, mine, sp = 0u;
    for (;;) {
        sum = 0u; cnt = 0u; mine = 0u;
#pragma unroll
        for (unsigned j = 0; j < 16; ++j) { const unsigned c = xb_ld(&bar[XB_XCNT(j)]); sum += c; cnt += (c > 0u) ? 1u : 0u; mine = (j == x) ? c : mine; }
        if (sum == G) break;
        __builtin_amdgcn_s_sleep(1);
        if ((++sp & 255u) == 0u) { if (xb_ld(&bar[XB_TMO])) break; if (sp > XB_SPIN_CAP) { atomicAdd(&bar[XB_TMO], 1u); break; } }
    }
    nloc = mine > 0u ? mine : 1u; nx = cnt > 0u ? cnt : 1u;
}

__device__ __forceinline__ void xcd_barrier(const XcdBarrier& b, bool leader) {
    asm volatile("s_waitcnt vmcnt(0)" ::: "memory");
    __syncthreads();
    if (leader) {
        unsigned* bar = b.bar;
        __builtin_amdgcn_s_waitcnt(0);
        unsigned nloc = b.st[0], nx = b.st[1];
        if (nloc == 0u) { xcd_barrier_complete(bar, b.x, nloc, nx); b.st[0] = nloc; b.st[1] = nx; }
        const unsigned old = xb_add(&bar[XB_XSUB(b.x)], 1u);
        const unsigned gen = old / nloc;
        if (old + 1u == (gen + 1u) * nloc) {
            __builtin_amdgcn_fence(__ATOMIC_RELEASE, "agent");
            asm volatile("s_waitcnt vmcnt(0)" ::: "memory");
            const unsigned og = xb_add(&bar[XB_TOP], 1u);
            const unsigned tg = og / nx;
            if (og + 1u == (tg + 1u) * nx) xb_add(&bar[XB_TOPGEN], 1u);
            else XB_SPIN(xb_ld(&bar[XB_TOPGEN]) == tg, bar);
            __builtin_amdgcn_fence(__ATOMIC_ACQUIRE, "agent");
            xb_add(&bar[XB_XGEN(b.x)], 1u);
            asm volatile("s_waitcnt vmcnt(0)" ::: "memory");
        } else {
            XB_SPIN(xb_ld(&bar[XB_XGEN(b.x)]) == gen, bar);
            __builtin_amdgcn_fence(__ATOMIC_ACQUIRE, "agent");
            asm volatile("s_waitcnt vmcnt(0)" ::: "memory");
        }
    }
    __syncthreads();
}


__global__ void __launch_bounds__(NWAVES * 64, 2) fwd_kernel(Args a_) {
    extern __shared__ __attribute__((aligned(16))) unsigned char lds_raw[];
    cg::grid_group grid = cg::this_grid();
    LAS unsigned char* lds = (LAS unsigned char*)lds_raw;
    const int wave0 = __builtin_amdgcn_readfirstlane(threadIdx.x >> 6);
    volatile LAS unsigned* topw = (volatile LAS unsigned*)(lds + LDS_BYTES - 64);
    if (threadIdx.x < 4) topw[threadIdx.x] = 0u;
    if (threadIdx.x == 0) { unsigned* ctl = (unsigned*)(a_.ws + WS_CTL); const unsigned xcc = xb_xcc_id(); unsigned rank = 99u;
                            if (xcc < 8u) rank = __hip_atomic_fetch_add(ctl + 3584 + 64 * xcc, 1u, __ATOMIC_RELAXED, __HIP_MEMORY_SCOPE_AGENT);
                            if (rank >= 32u || gridDim.x != 256u) __hip_atomic_store(ctl + 3584 + 64 * 8, 1u, __ATOMIC_RELAXED, __HIP_MEMORY_SCOPE_AGENT);
                            topw[4] = rank * 8u + xcc; }
    __syncthreads();
    grid.sync();
    if (threadIdx.x == 0) { if (__hip_atomic_load((unsigned*)(a_.ws + WS_CTL) + 3584 + 64 * 8, __ATOMIC_RELAXED, __HIP_MEMORY_SCOPE_AGENT) != 0u) topw[4] = blockIdx.x; }
    (void)xcd_barrier_post((unsigned*)(a_.ws + WS_CTL), topw, threadIdx.x == 0);
    __syncthreads();
#ifndef PROBE_MASK
#define PROBE_MASK 0
#endif
#ifndef PROBE_REPS
#define PROBE_REPS 1
#endif
    int ph = 0, nrep = 0;
#pragma unroll 1
    while (ph < 15) {
        const bool probe_pass = ((PROBE_MASK >> ph) & 1) && nrep < PROBE_REPS;
        int G = gridDim.x; asm volatile("" : "+s"(G));
        int bx = (int)((volatile LAS unsigned*)(lds + LDS_BYTES - 64))[4]; bx = __builtin_amdgcn_readfirstlane(bx); asm volatile("" : "+s"(bx));
        const int vcu = (G % 8 == 0) ? (bx % 8) * (G / 8) + bx / 8 : bx;
        int wv = wave0; asm volatile("" : "+s"(wv));
        unsigned z0 = 0u; asm volatile("" : "+s"(z0));
        int tid = wv * 64 + (int)__builtin_amdgcn_mbcnt_hi(~0u, __builtin_amdgcn_mbcnt_lo(~0u, z0)); asm volatile("" : "+v"(tid));
        typedef const __attribute__((address_space(4))) Args* kargs_t;
        kargs_t ap = (kargs_t)__builtin_amdgcn_kernarg_segment_ptr(); asm volatile("" : "+s"(ap));
        const Args& a = *(const Args*)ap;
        unsigned char* ws = a.ws; asm volatile("" : "+s"(ws));
        const int lane = tid & 63, wave = __builtin_amdgcn_readfirstlane(tid >> 6);
        bf16* X = (bf16*)(ws + WS_X);
        const bool is_gemm = (ph == 1 || ph == 3 || ph == 4 || ph == 6 || ph == 7 || ph == 10 || ph == 11 || ph == 13);
        if (is_gemm) {
            pg8::Gemm g; pg8::EpiAny E; E.ws = ws; E.out = a.out; E.b_f = a.in[I_BF]; E.sel = 0;
            g.M = MP; g.lda = 1024; g.apair = 256; g.K = 1024; g.A = X;
            if (ph == 1)       { g.Bt = (const bf16*)(ws + WS_WAIN); g.N = 3072; E.mode = pg8::EPI_MIX; }
            else if (ph == 3)  { g.A = (const bf16*)(ws + WS_MB); g.Bt = (const bf16*)(ws + WS_WAOUT); g.N = 1024; E.mode = pg8::EPI_RESID; E.sel = 1; }
            else if (ph == 4 || ph == 11) { const int l = ph == 11; g.Bt = (const bf16*)(ws + WS_WUP) + (size_t)l * FF2 * 1024; g.N = FF2; E.mode = pg8::EPI_UP; E.sel = l ? 3 : 1; }
            else if (ph == 6 || ph == 13) { const int l = ph == 13; g.A = (const bf16*)(ws + WS_UP); g.Bt = (const bf16*)(ws + WS_WDN) + (size_t)l * 1024 * FF; g.N = 1024; g.K = FF; g.lda = FF2; g.apair = 512;
                                 E.mode = pg8::EPI_RESID; E.sel = l ? 4 : 2; }
            else if (ph == 7)  { g.Bt = (const bf16*)(ws + WS_WKVQ); g.N = 3328; E.mode = pg8::EPI_KVQ; E.sel = 2; }
            else               { g.A = (const bf16*)(ws + WS_QB); g.Bt = (const bf16*)(ws + WS_WO); g.N = 1024; E.mode = pg8::EPI_RESID; E.sel = 3; }
#ifdef PROBE_DENSE_A
            if (probe_pass && (ph == 6 || ph == 13)) { g.lda = FF; g.apair = 256; }
#endif
            const bool upg = (ph == 4 || ph == 11 || ph == 7);
            pg8::StaticOrder S; S.init(upg ? M : MP, g.N, G, bx);
#ifdef PROBE_MODE
            if (probe_pass) E.mode = PROBE_MODE;
#elif !defined(PROBE_FULL)
            if (probe_pass) E.mode = pg8::EPI_NOP;
#endif
#ifndef SKIP_GEMM
            pg8::gemm_phase<pg8::EpiAny, pg8::StaticOrder, PG8_ALIGN, PG8_SP2>(lds, g, S, E, tid);
            if (!upg) {
              int wv2 = wave0; asm volatile("" : "+s"(wv2));
              unsigned z2 = 0u; asm volatile("" : "+s"(z2));
              int tid2 = wv2 * 64 + (int)__builtin_amdgcn_mbcnt_hi(~0u, __builtin_amdgcn_mbcnt_lo(~0u, z2)); asm volatile("" : "+v"(tid2));
              int G2 = gridDim.x; asm volatile("" : "+s"(G2)); int bx2 = (int)((volatile LAS unsigned*)(lds + LDS_BYTES - 64))[4]; bx2 = __builtin_amdgcn_readfirstlane(bx2); asm volatile("" : "+s"(bx2));
              const int vcu2 = (G2 % 8 == 0) ? (bx2 % 8) * (G2 / 8) + bx2 / 8 : bx2;
              if (ph == 3 || ph == 6 || ph == 10 || ph == 13) pg8::gemm_small64_resid(lds, g, MP, vcu2, G2, E.ws, E.sel, tid2, probe_pass);
              else pg8::gemm_small<pg8::EpiAny>(lds, g, MP, MS / 64, vcu2, G2, E, tid2);
            }
#endif
        } else if (ph == 0) {
#ifndef SKIP_P0
            p0_prologue(a, lds, vcu, G, wave, lane);
#endif
        } else if (ph == 2) {
#ifndef SKIP_P2
            p2_mixer(a, vcu, G, tid);
#endif
        } else if (ph == 5 || ph == 12) {
#ifndef SKIP_P5
            p5_ffn_elem(a, ph == 12, vcu, G, wave, lane, probe_pass);
#endif
        } else if (ph == 8) {
#ifndef SKIP_P8
            for (int bh = vcu; bh < 64; bh += G) p8_scan(a, bh, lds, wave, lane);
            if (!probe_pass) for (int un = vcu; un < 512; un += G) sample_unit(a, un >> 4, un & 15, lds, tid, lane, wave);
#endif
        } else if (ph == 9) {
            const attn_body::AttnTensors AT{(const attn_body::bf16*)(ws + WS_QB), (const attn_body::bf16*)(ws + WS_KB), (const attn_body::bf16*)(ws + WS_VB), (attn_body::bf16*)(ws + (probe_pass ? WS_BIG + 3 * X_BYTES : WS_QB)), (const float*)(ws + WS_CS), (const float*)(ws + WS_TOT)};
            const attn_body::StaticOrder S((int)G, (int)bx);
#ifndef SKIP_ATTN
            attn_body::attn_phase<attn_body::StaticOrder>((char*)lds_raw, AT, S, tid);
#endif
        } else {
#ifndef SKIP_P14
            p14_final(a, vcu, G, wave, lane);
#endif
        }
        if (probe_pass) ++nrep; else { ++ph; nrep = 0; }
        if (ph < 15) { XcdBarrier xb; xb.bar = (unsigned*)(ws + WS_CTL); xb.x = xb_xcc_id(); xb.st = (volatile LAS unsigned*)(lds + LDS_BYTES - 64); int wv3 = wave0; asm volatile("" : "+s"(wv3)); unsigned z3 = 0u; asm volatile("" : "+s"(z3));
                       const bool leader = (wv3 == 0) && (__builtin_amdgcn_mbcnt_hi(~0u, __builtin_amdgcn_mbcnt_lo(~0u, z3)) == 0u);
                       xcd_barrier(xb, leader); }
    }
}

extern "C" void kernel_launch(void* const* d_in, const int* in_sizes, int n_in, void* d_out, int out_size, void* d_ws, size_t ws_size, hipStream_t stream) {
    static int grid = 0;
    if (grid == 0) {
        if (n_in != 22 || out_size != (int)pg8::O_END || ws_size < WS_END) { fprintf(stderr, "kernel_launch: unexpected shapes: n_in %d out %d ws %zu (need %zu)\n", n_in, out_size, ws_size, (size_t)WS_END); grid = -1; return; }
        int dev = 0, cus = 0, per_cu = 0;
        if (hipGetDevice(&dev) != hipSuccess || hipDeviceGetAttribute(&cus, hipDeviceAttributeMultiprocessorCount, dev) != hipSuccess) { grid = -1; return; }
        if (hipFuncSetAttribute((const void*)fwd_kernel, hipFuncAttributeMaxDynamicSharedMemorySize, LDS_BYTES) != hipSuccess) { fprintf(stderr, "kernel_launch: hipFuncSetAttribute failed\n"); grid = -1; return; }
        if (hipOccupancyMaxActiveBlocksPerMultiprocessor(&per_cu, (const void*)fwd_kernel, NWAVES * 64, LDS_BYTES) != hipSuccess || per_cu < 1) { fprintf(stderr, "kernel_launch: occupancy query says %d\n", per_cu); per_cu = 1; }
        (void)hipGetLastError();
        grid = cus;
        if (grid != 256) fprintf(stderr, "kernel_launch: note: %d CUs (attention order assumes 256)\n", grid);
    }
    if (grid < 0) return;
    if (hipMemsetAsync((char*)d_ws + WS_CTL, 0, 16640, stream) != hipSuccess) { fprintf(stderr, "kernel_launch: memset failed\n"); return; }
    Args a{};
    for (int i = 0; i < 22; ++i) a.in[i] = (const float*)d_in[i];
    a.out = (float*)d_out; a.ws = (unsigned char*)d_ws;
    void* args[] = {&a};
    hipError_t e = hipLaunchCooperativeKernel((const void*)fwd_kernel, dim3(grid), dim3(NWAVES * 64), args, LDS_BYTES, stream);
    if (e != hipSuccess) fprintf(stderr, "kernel_launch: cooperative launch failed: %s (grid %d)\n", hipGetErrorString(e), grid);
}
```
